# Optimizing an MI355X kernel written in HIP

```python
import math
import jax, jax.numpy as jnp
from jax import lax
import numpy as np

D_MODEL = 1024
BATCH = 16
SEQ = 2048
DEPTH = 1

N_MEM = 256
HEAD_DIM = 64
ATT_HEADS = 8
ATT_KV_HEADS = 2
ATT_WIDTH = ATT_HEADS * HEAD_DIM
KV_WIDTH = ATT_KV_HEADS * HEAD_DIM
IDX_HEADS = 8
IDX_DIM = 32
TOPK_MAX = 256
Q_BLOCK = 128
SSM_WIDTH = D_MODEL // 4
SSM_GROUP = 16
SSM_GROUPS = SSM_WIDTH // SSM_GROUP
SSM_STATE = 64
DT_MIN = 0.001
DT_MAX = 0.1
MEM_HEADS = 4
MEM_WIDTH = MEM_HEADS * HEAD_DIM
MIX_WIDTH = ATT_WIDTH + SSM_WIDTH + MEM_WIDTH
ROPE_THETA = 500000.0
ROPE_FRAC = 4
LN_EPS = 1e-5
DN_ALPHA = (2.0 * DEPTH) ** 0.25
DN_BETA = (8.0 * DEPTH) ** -0.25

SPLITS = [
    ATT_WIDTH,
    KV_WIDTH,
    KV_WIDTH,
    IDX_HEADS * IDX_DIM,
    IDX_DIM,
    IDX_HEADS,
    ATT_WIDTH,
    SSM_WIDTH,
    SSM_WIDTH,
    MEM_WIDTH,
    MEM_WIDTH,
]
IN_WIDTH = int(sum(SPLITS))
SPLIT_POINTS = [int(s) for s in np.cumsum(SPLITS)[:-1]]

kernel_name = "hymba_dsa_s5_memxattn_deepnorm"


def rope_partial(x, pos):
    d = x.shape[-1]
    r = d // ROPE_FRAC
    half = r // 2
    inv = ROPE_THETA ** (-jnp.arange(0, half, dtype=jnp.float32) * 2.0 / r)
    ang = pos.astype(jnp.float32)[:, None] * inv[None, :]
    cos = jnp.cos(ang)[:, None, :]
    sin = jnp.sin(ang)[:, None, :]
    xf = x.astype(jnp.float32)
    x1, x2, xp = xf[..., :half], xf[..., half:r], xf[..., r:]
    out = jnp.concatenate([x1 * cos - x2 * sin, x2 * cos + x1 * sin, xp], axis=-1)
    return out.astype(x.dtype)


def dsa_attention(q, k, v, q_idx, k_idx, w_idx):
    B, L = q.shape[0], q.shape[1]
    topk = min(TOPK_MAX, L // 4)
    nb = L // Q_BLOCK
    rep = ATT_HEADS // ATT_KV_HEADS
    key_pos = jnp.arange(L)
    k_idx_f = k_idx.astype(jnp.float32)
    gather = jax.vmap(lambda a, i: a[i])

    def to_blocks(a):
        return a.reshape((B, nb, Q_BLOCK) + a.shape[2:]).swapaxes(0, 1)

    def block(args):
        qb, qib, wb, start = args
        qpos = start + jnp.arange(Q_BLOCK)
        s = jnp.einsum('bqhd,bsd->bqhs', qib.astype(jnp.float32), k_idx_f)
        score = jnp.einsum('bqh,bqhs->bqs', wb.astype(jnp.float32), jax.nn.relu(s))
        causal = key_pos[None, :] <= qpos[:, None]
        score = jnp.where(causal[None], score, -jnp.inf)
        _, idx = lax.top_k(score, topk)
        valid = idx <= qpos[None, :, None]
        kg = gather(k, idx)
        vg = gather(v, idx)
        qg = qb.reshape(B, Q_BLOCK, ATT_KV_HEADS, rep, HEAD_DIM)
        logits = jnp.einsum('bqgrd,bqkgd->bqgrk', qg, kg).astype(jnp.float32) * (HEAD_DIM ** -0.5)
        logits = jnp.where(valid[:, :, None, None, :], logits, -jnp.inf)
        p = jax.nn.softmax(logits, axis=-1).astype(v.dtype)
        o = jnp.einsum('bqgrk,bqkgd->bqgrd', p, vg)
        return o.reshape(B, Q_BLOCK, ATT_WIDTH)

    starts = jnp.arange(nb) * Q_BLOCK
    out = lax.map(block, (to_blocks(q), to_blocks(q_idx), to_blocks(w_idx), starts))
    return out.swapaxes(0, 1).reshape(B, L, ATT_WIDTH)


def s5_scan(u, lam_re, lam_im, log_dt, b_re, b_im, c_re, c_im, d_skip):
    f32 = jnp.float32
    lam = lax.complex(lam_re.astype(f32), lam_im.astype(f32))
    dt = jnp.exp(log_dt.astype(f32))[:, None]
    lam_bar = jnp.exp(lam * dt)
    b = lax.complex(b_re.astype(f32), b_im.astype(f32))
    b_bar = ((lam_bar - 1.0) / lam)[:, :, None] * b
    uf = u.astype(f32)
    bu = jnp.einsum('gpn,blgn->blgp', b_bar, uf.astype(jnp.complex64))
    a = jnp.broadcast_to(lam_bar, bu.shape)

    def combine(e1, e2):
        a1, b1 = e1
        a2, b2 = e2
        return a1 * a2, a2 * b1 + b2

    _, states = lax.associative_scan(combine, (a, bu), axis=1)
    c = lax.complex(c_re.astype(f32), c_im.astype(f32))
    y = jnp.einsum('gnp,blgp->blgn', c, states).real + d_skip.astype(f32) * uf
    return y.astype(u.dtype)


def layer_norm(h, g, b):
    hf = h.astype(jnp.float32)
    mu = jnp.mean(hf, axis=-1, keepdims=True)
    var = jnp.mean(jnp.square(hf - mu), axis=-1, keepdims=True)
    return ((hf - mu) * lax.rsqrt(var + LN_EPS) * g.astype(jnp.float32) + b.astype(jnp.float32))


def setup_inputs(seed: int = 0) -> dict:
    key = jax.random.key(seed)
    ks = jax.random.split(key, 20)
    f32 = jnp.float32
    G, P, N = SSM_GROUPS, SSM_STATE, SSM_GROUP
    x = jax.random.normal(ks[0], (BATCH, SEQ, D_MODEL), f32)
    mem = jax.random.normal(ks[1], (BATCH, N_MEM, D_MODEL), f32)
    w_in = jax.random.normal(ks[2], (D_MODEL, IN_WIDTH), f32) * D_MODEL ** -0.5
    w_mem_kv = jax.random.normal(ks[3], (D_MODEL, 2 * MEM_WIDTH), f32) * D_MODEL ** -0.5
    n = jnp.arange(P, dtype=f32)
    lam_re = -0.5 + 0.01 * jax.random.normal(ks[4], (G, P), f32)
    lam_im = math.pi * n[None, :] + 0.01 * jax.random.normal(ks[5], (G, P), f32)
    log_dt = jax.random.uniform(ks[6], (G,), f32, math.log(DT_MIN), math.log(DT_MAX))
    b_re = jax.random.normal(ks[7], (G, P, N), f32) * (2.0 * N) ** -0.5
    b_im = jax.random.normal(ks[8], (G, P, N), f32) * (2.0 * N) ** -0.5
    c_re = jax.random.normal(ks[9], (G, N, P), f32) * (2.0 * P) ** -0.5
    c_im = jax.random.normal(ks[10], (G, N, P), f32) * (2.0 * P) ** -0.5
    d_skip = jax.random.normal(ks[11], (G, N), f32)
    w_glu = jax.random.normal(ks[12], (SSM_WIDTH, SSM_WIDTH), f32) * SSM_WIDTH ** -0.5
    b_glu = 0.01 * jax.random.normal(ks[13], (SSM_WIDTH,), f32)
    w_out = jax.random.normal(ks[14], (MIX_WIDTH, D_MODEL), f32) * (MIX_WIDTH ** -0.5) * DN_BETA
    ln_g = 1.0 + 0.02 * jax.random.normal(ks[15], (D_MODEL,), f32)
    ln_b = 0.02 * jax.random.normal(ks[16], (D_MODEL,), f32)
    return {"x": x, "mem": mem, "w_in": w_in, "w_mem_kv": w_mem_kv,
            "lam_re": lam_re, "lam_im": lam_im, "log_dt": log_dt,
            "b_re": b_re, "b_im": b_im, "c_re": c_re, "c_im": c_im, "d_skip": d_skip,
            "w_glu": w_glu, "b_glu": b_glu, "w_out": w_out, "ln_g": ln_g, "ln_b": ln_b}


def reference(x, mem, w_in, w_mem_kv, lam_re, lam_im, log_dt, b_re, b_im, c_re, c_im,
              d_skip, w_glu, b_glu, w_out, ln_g, ln_b):
    B, L, _ = x.shape
    pos = jnp.arange(L)
    mkv = jnp.einsum('bmd,de->bme', mem, w_mem_kv)
    m_k, m_v = jnp.split(mkv, 2, axis=-1)
    m_k = m_k.reshape(B, N_MEM, MEM_HEADS, HEAD_DIM)
    m_v = m_v.reshape(B, N_MEM, MEM_HEADS, HEAD_DIM)
    h = x
    for _ in range(DEPTH):
        z = jnp.einsum('bld,de->ble', h, w_in)
        (q, k, v, q_idx, k_idx, w_idx, g_att, u, g_ssm, q_mem, g_mem) = jnp.split(z, SPLIT_POINTS, axis=-1)

        q = rope_partial(q.reshape(B, L, ATT_HEADS, HEAD_DIM), pos)
        k = rope_partial(k.reshape(B, L, ATT_KV_HEADS, HEAD_DIM), pos)
        v = v.reshape(B, L, ATT_KV_HEADS, HEAD_DIM)
        q_idx = rope_partial(q_idx.reshape(B, L, IDX_HEADS, IDX_DIM), pos)
        k_idx = rope_partial(k_idx[:, :, None, :], pos)[:, :, 0, :]
        w_idx = w_idx * (IDX_HEADS ** -0.5 * IDX_DIM ** -0.5)
        o_att = dsa_attention(q, k, v, q_idx, k_idx, w_idx)

        y = s5_scan(u.reshape(B, L, SSM_GROUPS, SSM_GROUP), lam_re, lam_im, log_dt,
                    b_re, b_im, c_re, c_im, d_skip).reshape(B, L, SSM_WIDTH)
        y = jax.nn.gelu(y)
        o_ssm = y * jax.nn.sigmoid(jnp.einsum('blc,ce->ble', y, w_glu) + b_glu)

        qm = q_mem.reshape(B, L, MEM_HEADS, HEAD_DIM)
        sm = jnp.einsum('blhd,bmhd->bhlm', qm, m_k).astype(jnp.float32) * (HEAD_DIM ** -0.5)
        pm = jax.nn.softmax(sm, axis=-1).astype(m_v.dtype)
        o_mem = jnp.einsum('bhlm,bmhd->blhd', pm, m_v).reshape(B, L, MEM_WIDTH)

        cat = jnp.concatenate([o_att * jax.nn.silu(g_att),
                               o_ssm * jax.nn.silu(g_ssm),
                               o_mem * jax.nn.silu(g_mem)], axis=-1)
        sub = jnp.einsum('ble,ed->bld', cat, w_out)
        h = layer_norm(DN_ALPHA * h.astype(jnp.float32) + sub.astype(jnp.float32), ln_g, ln_b).astype(x.dtype)
    return h
```

```cpp
#include <hip/hip_runtime.h>
#include <hip/hip_cooperative_groups.h>
#include <cstdio>
namespace cg = cooperative_groups;

typedef unsigned short u16;
typedef __attribute__((ext_vector_type(8))) short bf16x8;
typedef __attribute__((ext_vector_type(4))) short s16x4;
typedef __attribute__((ext_vector_type(16))) float f32x16;
typedef __attribute__((ext_vector_type(2))) float f32x2;
typedef __attribute__((ext_vector_type(4))) float f32x4;
typedef __attribute__((ext_vector_type(4))) unsigned u32x4;
typedef __attribute__((ext_vector_type(2))) unsigned u32x2;
typedef __attribute__((ext_vector_type(2))) __bf16 bf16x2;

#define DI __device__ __forceinline__
#define MFMA(a, b, c) __builtin_amdgcn_mfma_f32_32x32x16_bf16((a), (b), (c), 0, 0, 0)

constexpr int NB = 16, SEQ = 2048, DM = 1024, NTOK = NB * SEQ;
constexpr int NZ = 2688;
constexpr int UROW = 1152;
constexpr int LDS_STRIDE = 144;
constexpr int SMEM_BYTES = (256 + 128) * LDS_STRIDE;
constexpr float NEG_INF = -__builtin_huge_valf();
constexpr float QSCALE = 0.125f * 1.4426950408889634f;

struct Params {
  const float *x, *mem, *w_in, *w_mem_kv, *lam_re, *lam_im, *log_dt, *b_re, *b_im, *c_re, *c_im, *d_skip,
      *w_glu, *b_glu, *w_out, *ln_g, *ln_b;
  float* out;
  u16 *winT, *woutT, *wmemT, *wgluT, *qb, *kb, *vT, *qib, *kib, *gate, *qm, *U, *mkb, *mvT, *E, *W3, *yact, *cat;
  float *wi, *Sbuf, *kern;
  float2* rope;
  u16* xb;
  u16* scratch;
  unsigned* mask;
  unsigned* bar;
  unsigned* ctr;
  float2* lnst;
};

__constant__ float c_inv8[8] = {1.0f, 0.19392274474868576f, 0.03760603093086393f, 0.007292664737217109f,
                                0.001414213562373095f, 0.0002742481756762073f, 5.318295896944988e-05f,
                                1.031338537721246e-05f};

DI unsigned pack2(float a, float b) {
  f32x2 v = {a, b};
  bf16x2 r = __builtin_convertvector(v, bf16x2);
  return __builtin_bit_cast(unsigned, r);
}
DI u16 f2bf(float a) { return (u16)(pack2(a, 0.f) & 0xffffu); }
DI float bf2f(u16 v) { return __uint_as_float(((unsigned)v) << 16); }
DI unsigned xb_add(unsigned* p, unsigned v);
DI unsigned xb_ld(unsigned* p);
DI int crow(int i, int h) { return (i & 3) + 8 * (i >> 2) + 4 * h; }
DI u32x2 pack4(float a, float b, float c, float d) { u32x2 r; r.x = pack2(a, b); r.y = pack2(c, d); return r; }
DI float bflo(unsigned u) { return __uint_as_float(u << 16); }
DI float bfhi(unsigned u) { return __uint_as_float(u & 0xffff0000u); }
DI float silu(float v) { return v / (1.f + __expf(-v)); }
DI float gelu_tanh(float v) {
  float u = 0.7978845608028654f * (v + 0.044715f * v * v * v);
  float e = __expf(-2.f * fabsf(u));
  float t = (1.f - e) / (1.f + e);
  t = u < 0.f ? -t : t;
  return 0.5f * v * (1.f + t);
}

DI void sincos_rev(double rev, double& c, double& s) {
  rev -= rint(rev);
  double q = rint(rev * 4.0);
  double r = (rev - q * 0.25) * 6.283185307179586476925;
  double r2 = r * r;
  double sp = r * (1.0 + r2 * (-1.0 / 6 + r2 * (1.0 / 120 + r2 * (-1.0 / 5040 + r2 * (1.0 / 362880 + r2 * (-1.0 / 39916800 + r2 * (1.0 / 6227020800.0)))))));
  double cp = 1.0 + r2 * (-0.5 + r2 * (1.0 / 24 + r2 * (-1.0 / 720 + r2 * (1.0 / 40320 + r2 * (-1.0 / 3628800 + r2 * (1.0 / 479001600.0 + r2 * (-1.0 / 87178291200.0)))))));
  int qi = ((int)q) & 3;
  if (qi == 0) { c = cp; s = sp; }
  else if (qi == 1) { c = -sp; s = cp; }
  else if (qi == 2) { c = -cp; s = -sp; }
  else { c = sp; s = -cp; }
}
DI void lam_pow(const Params& p, int g, int pp, int j, double& re, double& im) {
  double dt = exp((double)p.log_dt[g]);
  double lr = p.lam_re[g * 64 + pp], li = p.lam_im[g * 64 + pp];
  double mag = exp(lr * dt * (double)j);
  double c, s;
  sincos_rev(li * dt * (double)j * 0.15915494309189533577, c, s);
  re = mag * c; im = mag * s;
}
DI void zoh_factor(const Params& p, int g, int pp, double& fr, double& fi) {
  double lbr, lbi;
  lam_pow(p, g, pp, 1, lbr, lbi);
  double lr = p.lam_re[g * 64 + pp], li = p.lam_im[g * 64 + pp];
  double nr = lbr - 1.0, ni = lbi;
  double den = lr * lr + li * li;
  fr = (nr * lr + ni * li) / den;
  fi = (ni * lr - nr * li) / den;
}

template <bool A_F32, class Epi>
DI void gemm_tile(const void* Aptr, long lda, const u16* Bt, long ldb, int K, int rowbase, int colbase, Epi epi, char* smem) {
  int tid_ = threadIdx.x;
  asm volatile("" : "+v"(tid_));
  const int tid = tid_, lane = tid & 63, w = tid >> 6, wm = w >> 1, wn = w & 1, l32 = lane & 31, h = lane >> 5;
  char* sA = smem;
  char* sB = smem + 128 * LDS_STRIDE;
  f32x16 acc[2][2];
#pragma unroll
  for (int a = 0; a < 2; ++a)
#pragma unroll
    for (int b = 0; b < 2; ++b)
#pragma unroll
      for (int i = 0; i < 16; ++i) acc[a][b][i] = 0.f;

  f32x4 raf[A_F32 ? 8 : 1];
  u32x4 rab[A_F32 ? 1 : 4];
  u32x4 rb[4];

#define GEMM_LOAD_REGS(K0)                                                                      \
  {                                                                                             \
    if constexpr (A_F32) {                                                                      \
      const float* A_ = (const float*)Aptr;                                                     \
      _Pragma("unroll") for (int i = 0; i < 8; ++i) {                                           \
        int id = tid + 256 * i, row = id >> 4, cc = id & 15;                                    \
        raf[i] = *(const f32x4*)(A_ + (long)row * lda + (K0) + cc * 4);                        \
      }                                                                                         \
    } else {                                                                                    \
      const u16* A_ = (const u16*)Aptr;                                                         \
      _Pragma("unroll") for (int i = 0; i < 4; ++i) {                                           \
        int id = tid + 256 * i, row = id >> 3, cc = id & 7;                                     \
        rab[i] = *(const u32x4*)(A_ + (long)row * lda + (K0) + cc * 8);                         \
      }                                                                                         \
    }                                                                                           \
    _Pragma("unroll") for (int i = 0; i < 4; ++i) {                                             \
      int id = tid + 256 * i, row = id >> 3, cc = id & 7;                                       \
      rb[i] = *(const u32x4*)(Bt + (long)row * ldb + (K0) + cc * 8);                            \
    }                                                                                           \
  }
#define GEMM_STORE_LDS()                                                                        \
  {                                                                                             \
    if constexpr (A_F32) {                                                                      \
      _Pragma("unroll") for (int i = 0; i < 8; ++i) {                                           \
        int id = tid + 256 * i, row = id >> 4, cc = id & 15;                                    \
        u32x2 v;                                                                                \
        v.x = pack2(raf[i].x, raf[i].y);                                                        \
        v.y = pack2(raf[i].z, raf[i].w);                                                        \
        *(u32x2*)(sA + row * LDS_STRIDE + cc * 8) = v;                                          \
      }                                                                                         \
    } else {                                                                                    \
      _Pragma("unroll") for (int i = 0; i < 4; ++i) {                                           \
        int id = tid + 256 * i, row = id >> 3, cc = id & 7;                                     \
        *(u32x4*)(sA + row * LDS_STRIDE + cc * 16) = rab[i];                                    \
      }                                                                                         \
    }                                                                                           \
    _Pragma("unroll") for (int i = 0; i < 4; ++i) {                                             \
      int id = tid + 256 * i, row = id >> 3, cc = id & 7;                                       \
      *(u32x4*)(sB + row * LDS_STRIDE + cc * 16) = rb[i];                                       \
    }                                                                                           \
  }

  GEMM_LOAD_REGS(0);
  for (int k0 = 0; k0 < K; k0 += 64) {
    __syncthreads();
    GEMM_STORE_LDS();
    __syncthreads();
    if (k0 + 64 < K) GEMM_LOAD_REGS(k0 + 64);
    __builtin_amdgcn_sched_barrier(0);
#pragma unroll
    for (int ks = 0; ks < 4; ++ks) {
      bf16x8 af[2], bfr[2];
#pragma unroll
      for (int mi = 0; mi < 2; ++mi)
        af[mi] = *(const bf16x8*)(sA + (64 * wm + 32 * mi + l32) * LDS_STRIDE + (16 * ks + 8 * h) * 2);
#pragma unroll
      for (int ni = 0; ni < 2; ++ni)
        bfr[ni] = *(const bf16x8*)(sB + (64 * wn + 32 * ni + l32) * LDS_STRIDE + (16 * ks + 8 * h) * 2);
#pragma unroll
      for (int mi = 0; mi < 2; ++mi)
#pragma unroll
        for (int ni = 0; ni < 2; ++ni) acc[mi][ni] = MFMA(bfr[ni], af[mi], acc[mi][ni]);
    }
  }
#pragma unroll 1
  for (int t4 = 0; t4 < 4; ++t4) {
    f32x16 a;
#pragma unroll
    for (int i = 0; i < 16; ++i) {
      float lo = (t4 & 1) ? acc[0][1][i] : acc[0][0][i];
      float hi = (t4 & 1) ? acc[1][1][i] : acc[1][0][i];
      a[i] = (t4 & 2) ? hi : lo;
    }
    epi(rowbase + 64 * wm + 32 * (t4 >> 1), colbase + 64 * wn + 32 * (t4 & 1), a);
  }
}

template <class Epi>
DI void gemm_big(const u16* A, long lda, const u16* Bt, long ldb, int K, int rowbase, int colbase, Epi epi, char* smem) {
  int tid_ = threadIdx.x;
  asm volatile("" : "+v"(tid_));
  const int tid = tid_, lane = tid & 63, w = tid >> 6, wm = w >> 1, wn = w & 1, l32 = lane & 31, h = lane >> 5;
  char* sA = smem;
  char* sB = smem + 256 * LDS_STRIDE;
  f32x16 acc[4][2];
#pragma unroll
  for (int a = 0; a < 4; ++a)
#pragma unroll
    for (int b = 0; b < 2; ++b)
#pragma unroll
      for (int i = 0; i < 16; ++i) acc[a][b][i] = 0.f;
  u32x4 ra[8], rb[4];
  const int srow = tid >> 3, scc = tid & 7;
#define BIG_LOAD_REGS(K0)                                                                        \
  {                                                                                              \
    _Pragma("unroll") for (int i = 0; i < 8; ++i)                                                \
      ra[i] = *(const u32x4*)(A + (long)(srow + 32 * i) * lda + (K0) + scc * 8);                 \
    _Pragma("unroll") for (int i = 0; i < 4; ++i)                                                \
      rb[i] = *(const u32x4*)(Bt + (long)(srow + 32 * i) * ldb + (K0) + scc * 8);                \
  }
#define BIG_STORE_LDS()                                                                          \
  {                                                                                              \
    _Pragma("unroll") for (int i = 0; i < 8; ++i)                                                \
      *(u32x4*)(sA + (srow + 32 * i) * LDS_STRIDE + scc * 16) = ra[i];                           \
    _Pragma("unroll") for (int i = 0; i < 4; ++i)                                                \
      *(u32x4*)(sB + (srow + 32 * i) * LDS_STRIDE + scc * 16) = rb[i];                           \
  }
  BIG_LOAD_REGS(0);
  for (int k0 = 0; k0 < K; k0 += 64) {
    __syncthreads();
    BIG_STORE_LDS();
    __syncthreads();
    if (k0 + 64 < K) BIG_LOAD_REGS(k0 + 64);
    __builtin_amdgcn_sched_barrier(0);
    __builtin_amdgcn_s_setprio(1);
#pragma unroll
    for (int ks = 0; ks < 4; ++ks) {
      bf16x8 bfr[2];
#pragma unroll
      for (int ni = 0; ni < 2; ++ni)
        bfr[ni] = *(const bf16x8*)(sB + (64 * wn + 32 * ni + l32) * LDS_STRIDE + (16 * ks + 8 * h) * 2);
#pragma unroll
      for (int mi = 0; mi < 4; ++mi) {
        bf16x8 af = *(const bf16x8*)(sA + (128 * wm + 32 * mi + l32) * LDS_STRIDE + (16 * ks + 8 * h) * 2);
#pragma unroll
        for (int ni = 0; ni < 2; ++ni) acc[mi][ni] = MFMA(bfr[ni], af, acc[mi][ni]);
      }
    }
    __builtin_amdgcn_s_setprio(0);
  }
#pragma unroll 1
  for (int t8 = 0; t8 < 8; ++t8) {
    f32x16 a;
#pragma unroll
    for (int i = 0; i < 16; ++i) {
      float v0 = (t8 & 1) ? acc[0][1][i] : acc[0][0][i];
      float v1 = (t8 & 1) ? acc[1][1][i] : acc[1][0][i];
      float v2 = (t8 & 1) ? acc[2][1][i] : acc[2][0][i];
      float v3 = (t8 & 1) ? acc[3][1][i] : acc[3][0][i];
      float lo = (t8 & 2) ? v1 : v0;
      float hi = (t8 & 2) ? v3 : v2;
      a[i] = (t8 & 4) ? hi : lo;
    }
    epi(rowbase + 128 * wm + 32 * (t8 >> 1), colbase + 64 * wn + 32 * (t8 & 1), a);
  }
}

template <class TileFn, class Epi>
DI void gemm_big_stream(const u16* Abase, const u16* Bbase, int first, int step, int limit, TileFn tile_of, Epi epi, char* smem) {
  if (first >= limit) return;
  int tid_ = threadIdx.x;
  asm volatile("" : "+v"(tid_));
  const int tid = tid_, lane = tid & 63, w = tid >> 6, wm = w >> 1, wn = w & 1, l32 = lane & 31, h = lane >> 5;
  char* sA = smem;
  char* sB = smem + 256 * LDS_STRIDE;
  u32x4 ra[8], rb[4];
  const int srow = tid >> 3, scc = tid & 7;
#define STRM_LOAD_REGS(AP, BP, K0)                                                               \
  {                                                                                              \
    _Pragma("unroll") for (int i = 0; i < 8; ++i)                                                \
      ra[i] = *(const u32x4*)((AP) + (long)(srow + 32 * i) * 1024 + (K0) + scc * 8);             \
    _Pragma("unroll") for (int i = 0; i < 4; ++i)                                                \
      rb[i] = *(const u32x4*)((BP) + (long)(srow + 32 * i) * 1024 + (K0) + scc * 8);             \
  }
  int it = first, rt, ct;
  tile_of(it, rt, ct);
  const u16* A = Abase + (long)rt * 256 * 1024;
  const u16* Bt = Bbase + (long)ct * 128 * 1024;
  STRM_LOAD_REGS(A, Bt, 0);
  for (;;) {
    f32x16 acc[4][2];
#pragma unroll
    for (int a = 0; a < 4; ++a)
#pragma unroll
      for (int b = 0; b < 2; ++b)
#pragma unroll
        for (int i = 0; i < 16; ++i) acc[a][b][i] = 0.f;
    const int itn = it + step;
    const bool has_next = itn < limit;
    int rtn = rt, ctn = ct;
    if (has_next) tile_of(itn, rtn, ctn);
    const u16* An = Abase + (long)rtn * 256 * 1024;
    const u16* Btn = Bbase + (long)ctn * 128 * 1024;
    for (int k0 = 0; k0 < 1024; k0 += 64) {
      __syncthreads();
      BIG_STORE_LDS();
      __syncthreads();
      {
        const bool last = (k0 + 64 >= 1024);
        const u16* ap = last ? An : A;
        const u16* bp = last ? Btn : Bt;
        const int kn = last ? 0 : k0 + 64;
        STRM_LOAD_REGS(ap, bp, kn);
      }
      __builtin_amdgcn_sched_barrier(0);
      __builtin_amdgcn_s_setprio(1);
#pragma unroll
      for (int ks = 0; ks < 4; ++ks) {
        bf16x8 bfr[2];
#pragma unroll
        for (int ni = 0; ni < 2; ++ni)
          bfr[ni] = *(const bf16x8*)(sB + (64 * wn + 32 * ni + l32) * LDS_STRIDE + (16 * ks + 8 * h) * 2);
#pragma unroll
        for (int mi = 0; mi < 4; ++mi) {
          bf16x8 af = *(const bf16x8*)(sA + (128 * wm + 32 * mi + l32) * LDS_STRIDE + (16 * ks + 8 * h) * 2);
#pragma unroll
          for (int ni = 0; ni < 2; ++ni) acc[mi][ni] = MFMA(bfr[ni], af, acc[mi][ni]);
        }
      }
      __builtin_amdgcn_s_setprio(0);
    }
#pragma unroll 1
    for (int t8 = 0; t8 < 8; ++t8) {
      f32x16 a;
#pragma unroll
      for (int i = 0; i < 16; ++i) {
        float v0 = (t8 & 1) ? acc[0][1][i] : acc[0][0][i];
        float v1 = (t8 & 1) ? acc[1][1][i] : acc[1][0][i];
        float v2 = (t8 & 1) ? acc[2][1][i] : acc[2][0][i];
        float v3 = (t8 & 1) ? acc[3][1][i] : acc[3][0][i];
        float lo = (t8 & 2) ? v1 : v0;
        float hi = (t8 & 2) ? v3 : v2;
        a[i] = (t8 & 4) ? hi : lo;
      }
      epi(rt * 256 + 128 * wm + 32 * (t8 >> 1), ct * 128 + 64 * wn + 32 * (t8 & 1), a);
    }
    if (!has_next) break;
    it = itn; rt = rtn; ct = ctn; A = An; Bt = Btn;
  }
}

DI void gemm_big_ln(const Params& p, const u16* A, long lda, const u16* Bt, long ldb, int K, int rt, int ct, char* smem) {
  const int rowbase = rt * 256, colbase = ct * 128;
  int tid_ = threadIdx.x;
  asm volatile("" : "+v"(tid_));
  const int tid = tid_, lane = tid & 63, w = tid >> 6, wm = w >> 1, wn = w & 1, l32 = lane & 31, h = lane >> 5;
  char* sA = smem;
  char* sB = smem + 256 * LDS_STRIDE;
  f32x16 acc[4][2];
#pragma unroll
  for (int a = 0; a < 4; ++a)
#pragma unroll
    for (int b = 0; b < 2; ++b)
#pragma unroll
      for (int i = 0; i < 16; ++i) acc[a][b][i] = 0.f;
  u32x4 ra[8], rb[4];
  const int srow = tid >> 3, scc = tid & 7;
#define BIG_LOAD_REGS(K0)                                                                        \
  {                                                                                              \
    _Pragma("unroll") for (int i = 0; i < 8; ++i)                                                \
      ra[i] = *(const u32x4*)(A + (long)(srow + 32 * i) * lda + (K0) + scc * 8);                 \
    _Pragma("unroll") for (int i = 0; i < 4; ++i)                                                \
      rb[i] = *(const u32x4*)(Bt + (long)(srow + 32 * i) * ldb + (K0) + scc * 8);                \
  }
#define BIG_STORE_LDS()                                                                          \
  {                                                                                              \
    _Pragma("unroll") for (int i = 0; i < 8; ++i)                                                \
      *(u32x4*)(sA + (srow + 32 * i) * LDS_STRIDE + scc * 16) = ra[i];                           \
    _Pragma("unroll") for (int i = 0; i < 4; ++i)                                                \
      *(u32x4*)(sB + (srow + 32 * i) * LDS_STRIDE + scc * 16) = rb[i];                           \
  }
  BIG_LOAD_REGS(0);
  for (int k0 = 0; k0 < K; k0 += 64) {
    __syncthreads();
    BIG_STORE_LDS();
    __syncthreads();
    if (k0 + 64 < K) BIG_LOAD_REGS(k0 + 64);
    __builtin_amdgcn_sched_barrier(0);
    __builtin_amdgcn_s_setprio(1);
#pragma unroll
    for (int ks = 0; ks < 4; ++ks) {
      bf16x8 bfr[2];
#pragma unroll
      for (int ni = 0; ni < 2; ++ni)
        bfr[ni] = *(const bf16x8*)(sB + (64 * wn + 32 * ni + l32) * LDS_STRIDE + (16 * ks + 8 * h) * 2);
#pragma unroll
      for (int mi = 0; mi < 4; ++mi) {
        bf16x8 af = *(const bf16x8*)(sA + (128 * wm + 32 * mi + l32) * LDS_STRIDE + (16 * ks + 8 * h) * 2);
#pragma unroll
        for (int ni = 0; ni < 2; ++ni) acc[mi][ni] = MFMA(bfr[ni], af, acc[mi][ni]);
      }
    }
    __builtin_amdgcn_s_setprio(0);
  }
  const float ALPHA = 1.189207115002721f;
  float s1[4], s2[4];
  f32x4 xv[2][2][4];
#define LN_LOAD_X(S, MI)                                                                                          \
  {                                                                                                               \
    const long row_ = rowbase + 128 * wm + 32 * (MI) + l32;                                                        \
    _Pragma("unroll") for (int ni = 0; ni < 2; ++ni)                                                              \
    _Pragma("unroll") for (int q4 = 0; q4 < 4; ++q4)                                                              \
      xv[S][ni][q4] = *(const f32x4*)(p.x + row_ * 1024 + colbase + 64 * wn + 32 * ni + 8 * q4 + 4 * h);          \
  }
  LN_LOAD_X(0, 0);
#pragma unroll
  for (int mi = 0; mi < 4; ++mi) {
    if (mi < 3) LN_LOAD_X((mi + 1) & 1, mi + 1);
    __builtin_amdgcn_sched_barrier(0);
    float a1 = 0.f, a2 = 0.f;
#pragma unroll
    for (int ni = 0; ni < 2; ++ni)
#pragma unroll
      for (int q4 = 0; q4 < 4; ++q4) {
        const f32x4 xq = xv[mi & 1][ni][q4];
        const float xs[4] = {xq.x, xq.y, xq.z, xq.w};
#pragma unroll
        for (int e = 0; e < 4; ++e) {
          const float hv = ALPHA * xs[e] + acc[mi][ni][4 * q4 + e];
          acc[mi][ni][4 * q4 + e] = hv;
          a1 += hv;
          a2 += hv * hv;
        }
      }
    a1 += __shfl_xor(a1, 32);
    a2 += __shfl_xor(a2, 32);
    s1[mi] = a1; s2[mi] = a2;
  }
  __syncthreads();
  float2* part = (float2*)smem;
  if (h == 0) {
#pragma unroll
    for (int mi = 0; mi < 4; ++mi) part[wn * 256 + 128 * wm + 32 * mi + l32] = make_float2(s1[mi], s2[mi]);
  }
  __syncthreads();
  {
    const float2 p0 = part[tid], p1 = part[256 + tid];
    const unsigned long long bits = (unsigned long long)__float_as_uint(p0.x + p1.x) | ((unsigned long long)__float_as_uint(p0.y + p1.y) << 32);
    __hip_atomic_store((unsigned long long*)&p.lnst[(long)(rt * 8 + ct) * 256 + tid], bits, __ATOMIC_RELAXED, __HIP_MEMORY_SCOPE_AGENT);
  }
  asm volatile("s_waitcnt vmcnt(0)" ::: "memory");
  __syncthreads();
  if (tid == 0) {
    (void)xb_add(&p.ctr[4300 + rt], 1u);
    unsigned sp = 0;
    while (xb_ld(&p.ctr[4300 + rt]) < 8u) { __builtin_amdgcn_s_sleep(1); if (++sp > (1u << 18)) break; }
  }
  __syncthreads();
  float mu[4], rs[4];
  unsigned long long sv[4][8];
#pragma unroll
  for (int mi = 0; mi < 4; ++mi)
#pragma unroll
    for (int c = 0; c < 8; ++c)
      sv[mi][c] = __hip_atomic_load((unsigned long long*)&p.lnst[(long)(rt * 8 + c) * 256 + 128 * wm + 32 * mi + l32], __ATOMIC_RELAXED,
                                    __HIP_MEMORY_SCOPE_AGENT);
#pragma unroll
  for (int mi = 0; mi < 4; ++mi) {
    float t1 = 0.f, t2 = 0.f;
#pragma unroll
    for (int c = 0; c < 8; ++c) { t1 += __uint_as_float((unsigned)sv[mi][c]); t2 += __uint_as_float((unsigned)(sv[mi][c] >> 32)); }
    const float m_ = t1 * (1.f / 1024.f);
    const float var = fmaxf(t2 * (1.f / 1024.f) - m_ * m_, 0.f);
    mu[mi] = m_;
    rs[mi] = rsqrtf(var + 1e-5f);
  }
#pragma unroll
  for (int ni = 0; ni < 2; ++ni)
#pragma unroll
    for (int q4 = 0; q4 < 4; ++q4) {
      const int col = colbase + 64 * wn + 32 * ni + 8 * q4 + 4 * h;
      const f32x4 g4 = *(const f32x4*)(p.ln_g + col), b4 = *(const f32x4*)(p.ln_b + col);
#pragma unroll
      for (int mi = 0; mi < 4; ++mi) {
        const long row = rowbase + 128 * wm + 32 * mi + l32;
        f32x4 o;
        o.x = (acc[mi][ni][4 * q4 + 0] - mu[mi]) * rs[mi] * g4.x + b4.x;
        o.y = (acc[mi][ni][4 * q4 + 1] - mu[mi]) * rs[mi] * g4.y + b4.y;
        o.z = (acc[mi][ni][4 * q4 + 2] - mu[mi]) * rs[mi] * g4.z + b4.z;
        o.w = (acc[mi][ni][4 * q4 + 3] - mu[mi]) * rs[mi] * g4.w + b4.w;
        *(f32x4*)(p.out + row * 1024 + col) = o;
      }
    }
}


DI int vblock() { return (int)(blockIdx.x & 7) * (int)(gridDim.x >> 3) + (int)(blockIdx.x >> 3); }

DI void transpose_weight(const float* __restrict__ src, int src_ld, u16* __restrict__ dst, int n_rows, int kchunks, int gtid, int gsz, bool permute_in) {
  for (int i = gtid; i < n_rows * kchunks; i += gsz) {
    int n = i % n_rows, kc = i / n_rows;
    int orig = n;
    if (permute_in) orig = n < 1024 ? n : (n < 2560 ? n + 40 : (n < 2592 ? n - 2560 + 1024 : (n < 2600 ? n - 2592 + 1056 : -1)));
    unsigned r[4];
#pragma unroll
    for (int jj = 0; jj < 4; ++jj) {
      float a = 0.f, b = 0.f;
      if (orig >= 0) {
        a = src[(long)(kc * 8 + 2 * jj) * src_ld + orig];
        b = src[(long)(kc * 8 + 2 * jj + 1) * src_ld + orig];
      }
      r[jj] = pack2(a, b);
    }
    uint4 v; v.x = r[0]; v.y = r[1]; v.z = r[2]; v.w = r[3];
    *(uint4*)(dst + (long)n * (kchunks * 8) + kc * 8) = v;
  }
}

DI void phase0(const Params& p, char* smem) {
  const int tid = threadIdx.x;
  const int gtid = blockIdx.x * 128 + (tid & 127), gsz = gridDim.x * 128;
  if (tid < 128) {
  transpose_weight(p.w_in, 2600, p.winT, NZ, 128, gtid, gsz, true);
  transpose_weight(p.w_out, 1024, p.woutT, 1024, 128, gtid, gsz, false);
  transpose_weight(p.w_mem_kv, 512, p.wmemT, 512, 128, gtid, gsz, false);
  transpose_weight(p.w_glu, 256, p.wgluT, 256, 32, gtid, gsz, false);

  {
    const f32x4* __restrict__ xs = (const f32x4*)p.x;
    u32x4* __restrict__ xd = (u32x4*)p.xb;
    const long nitem = (long)NTOK * 1024 / 8;
    for (long i0 = gtid; i0 < nitem; i0 += 4L * gsz) {
      f32x4 a[4], b[4];
#pragma unroll
      for (int e = 0; e < 4; ++e) {
        long i = i0 + (long)e * gsz;
        if (i >= nitem) i = i0;
        a[e] = xs[2 * i]; b[e] = xs[2 * i + 1];
      }
#pragma unroll
      for (int e = 0; e < 4; ++e) {
        long i = i0 + (long)e * gsz;
        if (i < nitem) {
          u32x4 o;
          o.x = pack2(a[e].x, a[e].y); o.y = pack2(a[e].z, a[e].w); o.z = pack2(b[e].x, b[e].y); o.w = pack2(b[e].z, b[e].w);
          xd[i] = o;
        }
      }
    }
  }
  } else {
  for (int i = gtid; i < 2048 * 8; i += gsz) {
    float ang = (float)(i >> 3) * c_inv8[i & 7];
    double c, s;
    sincos_rev((double)ang * 0.15915494309189533577, c, s);
    p.rope[i] = make_float2((float)c, (float)s);
  }
  for (int i = gtid; i < 16 * 64 * 64; i += gsz) {
    int g = i >> 12, pp = (i >> 6) & 63, s = i & 63;
    double pr, pi, fr, fi;
    lam_pow(p, g, pp, 63 - s, pr, pi);
    zoh_factor(p, g, pp, fr, fi);
    double cr = pr * fr - pi * fi, ci = pr * fi + pi * fr;
    unsigned re[8], im[8];
#pragma unroll
    for (int m2 = 0; m2 < 8; ++m2) {
      float vr[2], vi[2];
#pragma unroll
      for (int e = 0; e < 2; ++e) {
        int m = 2 * m2 + e;
        double br = p.b_re[(g * 64 + pp) * 16 + m], bi = p.b_im[(g * 64 + pp) * 16 + m];
        vr[e] = (float)(cr * br - ci * bi);
        vi[e] = (float)(cr * bi + ci * br);
      }
      re[m2] = pack2(vr[0], vr[1]);
      im[m2] = pack2(vi[0], vi[1]);
    }
    uint4* dr = (uint4*)(p.E + ((long)(g * 128 + pp) * 1024 + s * 16));
    uint4* di = (uint4*)(p.E + ((long)(g * 128 + 64 + pp) * 1024 + s * 16));
    uint4 v;
    v.x = re[0]; v.y = re[1]; v.z = re[2]; v.w = re[3]; dr[0] = v;
    v.x = re[4]; v.y = re[5]; v.z = re[6]; v.w = re[7]; dr[1] = v;
    v.x = im[0]; v.y = im[1]; v.z = im[2]; v.w = im[3]; di[0] = v;
    v.x = im[4]; v.y = im[5]; v.z = im[6]; v.w = im[7]; di[1] = v;
  }
  for (int i = gtid; i < 16 * 64 * 64; i += gsz) {
    int g = i >> 12, t = (i >> 6) & 63, pp = i & 63;
    double pr, pi;
    lam_pow(p, g, pp, t + 1, pr, pi);
#pragma unroll 4
    for (int n = 0; n < 16; ++n) {
      double cr = p.c_re[(g * 16 + n) * 64 + pp], ci = p.c_im[(g * 16 + n) * 64 + pp];
      long row = (long)g * 1024 + t * 16 + n;
      *(unsigned*)(p.W3 + row * UROW + 1024 + 2 * pp) = pack2((float)(cr * pr - ci * pi), (float)(-(cr * pi + ci * pr)));
    }
  }
  }
  {
    float2* s_lp = (float2*)smem;
    float2* s_bb = (float2*)(smem + 1024);
    double2* s_f = (double2*)(smem + 16384);
    for (int it = blockIdx.x; it < 16 * 64; it += gridDim.x) {
      int g = it >> 6, j = it & 63;
      __syncthreads();
      if (tid < 64) {
        double pr, pi, fr, fi;
        lam_pow(p, g, tid, j, pr, pi);
        zoh_factor(p, g, tid, fr, fi);
        s_lp[tid] = make_float2((float)pr, (float)pi);
        s_f[tid] = make_double2(fr, fi);
      }
      __syncthreads();
#pragma unroll
      for (int e = 0; e < 4; ++e) {
        int idx = tid + 256 * e, pp = idx >> 4, m = idx & 15;
        double br = p.b_re[(g * 64 + pp) * 16 + m], bi = p.b_im[(g * 64 + pp) * 16 + m];
        double2 f = s_f[pp];
        s_bb[idx] = make_float2((float)(f.x * br - f.y * bi), (float)(f.x * bi + f.y * br));
      }
      __syncthreads();
      int n = tid >> 4, m = tid & 15;
      f32x4 crv[16], civ[16];
#pragma unroll
      for (int q = 0; q < 16; ++q) {
        crv[q] = ((const f32x4*)(p.c_re + (g * 16 + n) * 64))[q];
        civ[q] = ((const f32x4*)(p.c_im + (g * 16 + n) * 64))[q];
      }
      float accv = 0.f;
#pragma unroll
      for (int q = 0; q < 16; ++q) {
        float cr4[4] = {crv[q].x, crv[q].y, crv[q].z, crv[q].w}, ci4[4] = {civ[q].x, civ[q].y, civ[q].z, civ[q].w};
#pragma unroll
        for (int e = 0; e < 4; ++e) {
          int pp = 4 * q + e;
          float2 lp = s_lp[pp], bb = s_bb[pp * 16 + m];
          float tr = cr4[e] * lp.x - ci4[e] * lp.y, ti = cr4[e] * lp.y + ci4[e] * lp.x;
          accv += tr * bb.x - ti * bb.y;
        }
      }
      p.kern[((g * 64 + j) * 16 + n) * 16 + m] = accv;
    }
    __syncthreads();
  }
}


DI void epi_inproj(const Params& p, int r0, int c0, const f32x16& acc) {
  const int lane = threadIdx.x & 63, l32 = lane & 31, h = lane >> 5;
  const long row = r0 + l32;
  const int pos = (int)row & 2047;
  if (c0 < 640) {
    float v[16];
#pragma unroll
    for (int i = 0; i < 16; ++i) v[i] = acc[i];
    if ((c0 & 63) == 0) {
      const f32x4* rp = (const f32x4*)(p.rope + pos * 8 + 4 * h);
      f32x4 t0 = rp[0], t1 = rp[1];
      float cc[4] = {t0.x, t0.z, t1.x, t1.z}, ss[4] = {t0.y, t0.w, t1.y, t1.w};
#pragma unroll
      for (int e = 0; e < 4; ++e) {
        float x1 = acc[e], x2 = acc[4 + e];
        v[e] = x1 * cc[e] - x2 * ss[e];
        v[4 + e] = x2 * cc[e] + x1 * ss[e];
      }
    }
    u16* dst = c0 < 512 ? p.qb + row * 512 + c0 : p.kb + row * 128 + (c0 - 512);
    const float qs = c0 < 512 ? QSCALE : 1.f;
#pragma unroll
    for (int q4 = 0; q4 < 4; ++q4)
      *(u32x2*)(dst + 8 * q4 + 4 * h) = pack4(v[4 * q4] * qs, v[4 * q4 + 1] * qs, v[4 * q4 + 2] * qs, v[4 * q4 + 3] * qs);
  } else if (c0 < 768) {
    const int b = (int)(row >> 11);
#pragma unroll
    for (int i = 0; i < 16; ++i) {
      int feat = c0 - 640 + crow(i, h), g = feat >> 6, d = feat & 63;
      p.vT[(long)((b * 2 + g) * 64 + d) * 2048 + pos] = f2bf(acc[i]);
    }
  } else if (c0 < 1024 || c0 == 2560) {
    float v[16];
#pragma unroll
    for (int i = 0; i < 16; ++i) v[i] = acc[i];
    const f32x4* rp = (const f32x4*)(p.rope + pos * 8);
    f32x4 t0 = rp[0], t1 = rp[1], t2 = rp[2], t3 = rp[3];
    float cc[4] = {t0.x, t1.x, t2.x, t3.x}, ss[4] = {t0.y, t1.y, t2.y, t3.y};
#pragma unroll
    for (int e = 0; e < 4; ++e) {
      float x = acc[e];
      float pv = __shfl_xor(x, 32);
      v[e] = h == 0 ? x * cc[e] - pv * ss[e] : x * cc[e] + pv * ss[e];
    }
    u16* dst = c0 < 1024 ? p.qib + row * 256 + (c0 - 768) : p.kib + row * 32;
#pragma unroll
    for (int q4 = 0; q4 < 4; ++q4) *(u32x2*)(dst + 8 * q4 + 4 * h) = pack4(v[4 * q4], v[4 * q4 + 1], v[4 * q4 + 2], v[4 * q4 + 3]);
  } else if (c0 < 1536 || (c0 >= 1792 && c0 < 2048) || (c0 >= 2304 && c0 < 2560)) {
    const int off = c0 < 1536 ? c0 - 1024 : (c0 < 2048 ? 512 + c0 - 1792 : 768 + c0 - 2304);
    u16* dst = p.gate + row * 1024 + off;
#pragma unroll
    for (int q4 = 0; q4 < 4; ++q4)
      *(u32x2*)(dst + 8 * q4 + 4 * h) = pack4(silu(acc[4 * q4]), silu(acc[4 * q4 + 1]), silu(acc[4 * q4 + 2]), silu(acc[4 * q4 + 3]));
  } else if (c0 < 1792) {
    const int b = (int)(row >> 11), c = pos >> 6, tl = pos & 63;
#pragma unroll
    for (int q4 = 0; q4 < 4; ++q4) {
      int f = c0 - 1536 + 8 * q4 + 4 * h, g = f >> 4, n0 = f & 15;
      *(u32x2*)(p.U + (long)((g * 16 + b) * 32 + c) * UROW + tl * 16 + n0) = pack4(acc[4 * q4], acc[4 * q4 + 1], acc[4 * q4 + 2], acc[4 * q4 + 3]);
    }
  } else if (c0 < 2304) {
    u16* dst = p.qm + row * 256 + (c0 - 2048);
#pragma unroll
    for (int q4 = 0; q4 < 4; ++q4)
      *(u32x2*)(dst + 8 * q4 + 4 * h) = pack4(acc[4 * q4] * QSCALE, acc[4 * q4 + 1] * QSCALE, acc[4 * q4 + 2] * QSCALE, acc[4 * q4 + 3] * QSCALE);
  } else if (c0 == 2592) {
    f32x4 o = {acc[0] * 0.0625f, acc[1] * 0.0625f, acc[2] * 0.0625f, acc[3] * 0.0625f};
    *(f32x4*)(p.wi + row * 8 + 4 * h) = o;
  }
}

DI void epi_memkv(const Params& p, int r0, int c0, const f32x16& acc) {
  const int lane = threadIdx.x & 63, l32 = lane & 31, h = lane >> 5;
  const long row = r0 + l32;
  if (c0 < 256) {
    u16* dst = p.mkb + row * 256 + c0;
#pragma unroll
    for (int q4 = 0; q4 < 4; ++q4) *(u32x2*)(dst + 8 * q4 + 4 * h) = pack4(acc[4 * q4], acc[4 * q4 + 1], acc[4 * q4 + 2], acc[4 * q4 + 3]);
  } else {
    const int b = (int)(row >> 8), m = (int)row & 255;
#pragma unroll
    for (int i = 0; i < 16; ++i) {
      int feat = c0 - 256 + crow(i, h), hm = feat >> 6, d = feat & 63;
      p.mvT[(long)((b * 4 + hm) * 64 + d) * 256 + m] = f2bf(acc[i]);
    }
  }
}

DI void w3_build(const Params& p, int first, int stride) {
  const int nitem = 16 * 1024 * 128;
  for (int i0 = first; i0 < nitem; i0 += 4 * stride) {
    f32x4 ka[4], kb[4];
#pragma unroll
    for (int e = 0; e < 4; ++e) {
      int i = i0 + e * stride;
      ka[e] = (f32x4){0.f, 0.f, 0.f, 0.f}; kb[e] = ka[e];
      if (i < nitem) {
        int row = i >> 7, ch = i & 127, s_ = ch >> 1, m0 = (ch & 1) * 8;
        int g = row >> 10, t = (row >> 4) & 63, n = row & 15;
        if (s_ <= t) {
          const float* kp = p.kern + ((g * 64 + (t - s_)) * 16 + n) * 16 + m0;
          ka[e] = *(const f32x4*)kp; kb[e] = *(const f32x4*)(kp + 4);
          if (s_ == t && (n >> 3) == (ch & 1)) {
            float dsk = p.d_skip[g * 16 + n];
            int k = n & 7;
            if (k == 0) ka[e].x += dsk; else if (k == 1) ka[e].y += dsk; else if (k == 2) ka[e].z += dsk; else if (k == 3) ka[e].w += dsk;
            else if (k == 4) kb[e].x += dsk; else if (k == 5) kb[e].y += dsk; else if (k == 6) kb[e].z += dsk; else kb[e].w += dsk;
          }
        }
      }
    }
#pragma unroll
    for (int e = 0; e < 4; ++e) {
      int i = i0 + e * stride;
      if (i < nitem) {
        int row = i >> 7, ch = i & 127;
        u32x4 o;
        o.x = pack2(ka[e].x, ka[e].y); o.y = pack2(ka[e].z, ka[e].w); o.z = pack2(kb[e].x, kb[e].y); o.w = pack2(kb[e].z, kb[e].w);
        *(u32x4*)(p.W3 + (long)row * UROW + ch * 8) = o;
      }
    }
  }
}

DI void phase1(const Params& p, char* smem) {
  const int n_g1 = 128 * 21, n_mkv = 32 * 4;
  if (gridDim.x == 512) {
    const int vb = vblock();
    gemm_big_stream(p.xb, p.winT, vb, 512, 2560, [](int it, int& rt, int& ct) { rt = it / 21; ct = it % 21; },
                    [&](int r0, int c0, const f32x16& a) { epi_inproj(p, r0, c0, a); }, smem);
    if (vb < 256) {
      int bt = 2560 + (vb >> 1), hf = vb & 1, rt = bt / 21, ct = bt % 21, r = rt * 256 + hf * 128;
      gemm_tile<false>(p.xb + (long)r * 1024, 1024, p.winT + (long)ct * 128 * 1024, 1024, 1024, r, ct * 128,
                       [&](int r0, int c0, const f32x16& a) { epi_inproj(p, r0, c0, a); }, smem);
    } else if (vb < 384) {
      int id = vb - 256, rt = id >> 2, ct = id & 3;
      gemm_tile<true>(p.mem + (long)rt * 128 * 1024, 1024, p.wmemT + (long)ct * 128 * 1024, 1024, 1024, rt * 128, ct * 128,
                      [&](int r0, int c0, const f32x16& a) { epi_memkv(p, r0, c0, a); }, smem);
    } else {
      w3_build(p, (vb - 384) * 256 + threadIdx.x, 128 * 256);
    }
    return;
  }
  for (int it = vblock(); it < n_g1 + n_mkv; it += gridDim.x) {
    if (it < n_g1) {
      int rt = it / 21, ct = it % 21;
      gemm_big(p.xb + (long)rt * 256 * 1024, 1024, p.winT + (long)ct * 128 * 1024, 1024, 1024, rt * 256, ct * 128,
               [&](int r0, int c0, const f32x16& a) { epi_inproj(p, r0, c0, a); }, smem);
    } else {
      int id = it - n_g1, rt = id >> 2, ct = id & 3;
      gemm_tile<true>(p.mem + (long)rt * 128 * 1024, 1024, p.wmemT + (long)ct * 128 * 1024, 1024, 1024, rt * 128, ct * 128,
                      [&](int r0, int c0, const f32x16& a) { epi_memkv(p, r0, c0, a); }, smem);
    }
  }
  w3_build(p, blockIdx.x * 256 + threadIdx.x, gridDim.x * 256);
}

DI unsigned fkey(float f) { unsigned u = __float_as_uint(f); return (u & 0x80000000u) ? ~u : (u | 0x80000000u); }
DI float funkey(unsigned k) { unsigned u = (k & 0x80000000u) ? (k & 0x7fffffffu) : ~k; return __uint_as_float(u); }

template <int NT>
DI void select_body(const Params& p, int b, int t0, int lane, int l32, int h, long tokbase) {
  asm volatile("" : "+v"(l32), "+v"(h));
  bf16x8 af[2];
  {
    int m = l32, mm = m & 3, hl = (m >> 2) & 1, jj = m >> 3;
    int tokA = 2 * hl + (jj >> 1), headA = 4 * (jj & 1) + mm;
    const u16* qa = p.qib + (tokbase + t0 + tokA) * 256 + headA * 32 + 8 * h;
    af[0] = *(const bf16x8*)qa;
    af[1] = *(const bf16x8*)(qa + 16);
  }
  float wv[2][8];
#pragma unroll
  for (int jt = 0; jt < 2; ++jt) {
    const float4* wp = (const float4*)(p.wi + (tokbase + t0 + 2 * h + jt) * 8);
    float4 a = wp[0], c = wp[1];
    wv[jt][0] = a.x; wv[jt][1] = a.y; wv[jt][2] = a.z; wv[jt][3] = a.w;
    wv[jt][4] = c.x; wv[jt][5] = c.y; wv[jt][6] = c.z; wv[jt][7] = c.w;
  }
  const int ntiles = ((t0 + 3) >> 5) + 1;
  const unsigned KEY_NINF = 0x007fffffu;
  unsigned sc[NT][2];
  unsigned kmax[2] = {0u, 0u}, kmin[2] = {0xffffffffu, 0xffffffffu};
  u32x4 kq0[2][4], kq1[2][4];
#define SEL_LOAD_GROUP(S, TG)                                                              \
  {                                                                                        \
    _Pragma("unroll") for (int e = 0; e < 4; ++e) {                                        \
      const u16* kp_ = p.kib + (tokbase + 32 * (4 * (TG) + e) + l32) * 32 + 8 * h;          \
      kq0[S][e] = *(const u32x4*)kp_;                                                      \
      kq1[S][e] = *(const u32x4*)(kp_ + 16);                                               \
    }                                                                                      \
  }
  SEL_LOAD_GROUP(0, 0);
#pragma unroll
  for (int tg = 0; tg < NT / 4; ++tg) {
    if (tg + 1 < NT / 4) SEL_LOAD_GROUP((tg + 1) & 1, tg + 1);
    __builtin_amdgcn_sched_barrier(0);
#pragma unroll
    for (int e = 0; e < 4; ++e) {
      const int tile = 4 * tg + e;
      f32x16 a;
#pragma unroll
      for (int i = 0; i < 16; ++i) a[i] = 0.f;
      a = MFMA(af[0], __builtin_bit_cast(bf16x8, kq0[tg & 1][e]), a);
      a = MFMA(af[1], __builtin_bit_cast(bf16x8, kq1[tg & 1][e]), a);
      const int key = 32 * tile + l32;
#pragma unroll
      for (int jt = 0; jt < 2; ++jt) {
        float pj[4];
#pragma unroll
        for (int j = 0; j < 4; ++j)
          pj[j] = __builtin_fmaf(wv[jt][j + 4], fmaxf(a[8 * jt + 4 + j], 0.f), wv[jt][j] * fmaxf(a[8 * jt + j], 0.f));
        float s = ((pj[0] + pj[1]) + (pj[2] + pj[3])) + 0.0f;
        int t = t0 + 2 * h + jt;
        unsigned k = key <= t ? fkey(s) : KEY_NINF;
        sc[tile][jt] = k;
        kmax[jt] = max(kmax[jt], k);
        kmin[jt] = min(kmin[jt], key <= t ? k : 0xffffffffu);
      }
    }
  }
#pragma unroll
  for (int jt = 0; jt < 2; ++jt)
#pragma unroll
    for (int o = 16; o >= 1; o >>= 1) {
      kmax[jt] = max(kmax[jt], (unsigned)__shfl_xor((int)kmax[jt], o));
      kmin[jt] = min(kmin[jt], (unsigned)__shfl_xor((int)kmin[jt], o));
    }
  unsigned lo[2], hi[2], thr[2];
  int chi[2], need[2];
  bool done[2];
#pragma unroll
  for (int jt = 0; jt < 2; ++jt) { lo[jt] = kmin[jt] - 1u; hi[jt] = kmax[jt]; chi[jt] = 0; need[jt] = 0; thr[jt] = 0; done[jt] = false; }
  for (int iter = 0; iter < 80; ++iter) {
    unsigned km[2];
#pragma unroll
    for (int jt = 0; jt < 2; ++jt) {
      if (!done[jt] && hi[jt] - lo[jt] <= 1u) { done[jt] = true; thr[jt] = hi[jt]; need[jt] = 256 - chi[jt]; }
      float fm = 0.5f * funkey(lo[jt]) + 0.5f * funkey(hi[jt]);
      unsigned k = fkey(fm);
      if (iter >= 7 || !(k > lo[jt] && k < hi[jt])) k = lo[jt] + ((hi[jt] - lo[jt]) >> 1);
      km[jt] = k;
    }
    if (__all(done[0] && done[1])) break;
    int cnt[2] = {0, 0};
#pragma unroll
    for (int tile = 0; tile < NT; ++tile) {
#pragma unroll
      for (int jt = 0; jt < 2; ++jt) cnt[jt] += (sc[tile][jt] > km[jt]) ? 1 : 0;
    }
#pragma unroll
    for (int jt = 0; jt < 2; ++jt) {
      cnt[jt] += __builtin_amdgcn_update_dpp(0, cnt[jt], 0xB1, 0xF, 0xF, true);
      cnt[jt] += __builtin_amdgcn_update_dpp(0, cnt[jt], 0x4E, 0xF, 0xF, true);
      cnt[jt] += __builtin_amdgcn_update_dpp(0, cnt[jt], 0x141, 0xF, 0xF, true);
      cnt[jt] += __builtin_amdgcn_update_dpp(0, cnt[jt], 0x140, 0xF, 0xF, true);
      const int ra0 = __builtin_amdgcn_readlane(cnt[jt], 0), ra1 = __builtin_amdgcn_readlane(cnt[jt], 16);
      const int rb0 = __builtin_amdgcn_readlane(cnt[jt], 32), rb1 = __builtin_amdgcn_readlane(cnt[jt], 48);
      int c = h ? (rb0 + rb1) : (ra0 + ra1);
      if (!done[jt]) {
        if (c == 256) { done[jt] = true; thr[jt] = km[jt]; need[jt] = 0; }
        else if (c > 256) lo[jt] = km[jt];
        else { hi[jt] = km[jt]; chi[jt] = c; }
      }
    }
  }
  unsigned W[2][2] = {{0u, 0u}, {0u, 0u}};
  int rem[2] = {need[0], need[1]};
  const bool anyties = __any(need[0] > 0 || need[1] > 0);
#pragma unroll
  for (int tile = 0; tile < NT; ++tile) {
    if (tile < ntiles) {
#pragma unroll
      for (int jt = 0; jt < 2; ++jt) {
        bool sel = sc[tile][jt] > thr[jt];
        if (anyties) {
          bool eq = (need[jt] > 0) && (sc[tile][jt] == thr[jt]);
          unsigned long long bm = __ballot(eq);
          unsigned myw = h ? (unsigned)(bm >> 32) : (unsigned)bm;
          int rank = __popc(myw & ((1u << l32) - 1u));
          sel = sel || (eq && rank < rem[jt]);
          rem[jt] = max(rem[jt] - __popc(myw), 0);
        }
        unsigned long long sm = __ballot(sel);
        unsigned word = h ? (unsigned)(sm >> 32) : (unsigned)sm;
        if (l32 == (tile & 31)) W[jt][tile >> 5] = word;
      }
    }
  }
#pragma unroll
  for (int jt = 0; jt < 2; ++jt) {
    int t = t0 + 2 * h + jt;
    p.mask[(tokbase + t) * 64 + l32] = W[jt][0];
    p.mask[(tokbase + t) * 64 + 32 + l32] = W[jt][1];
  }
}

DI void select_wave(const Params& p, int b, int t0) {
  int tid_ = threadIdx.x;
  asm volatile("" : "+v"(tid_));
  const int lane = tid_ & 63, l32 = lane & 31, h = lane >> 5;
  const long tokbase = (long)b * SEQ;
  if (t0 < 256) {
#pragma unroll
    for (int jt = 0; jt < 2; ++jt) {
      int t = t0 + 2 * h + jt;
#pragma unroll
      for (int w2 = 0; w2 < 2; ++w2) {
        int lo = (l32 + 32 * w2) * 32;
        unsigned word = (t >= lo + 31) ? 0xffffffffu : (t < lo ? 0u : ((2u << (t - lo)) - 1u));
        p.mask[(tokbase + t) * 64 + l32 + 32 * w2] = word;
      }
    }
    return;
  }
  const int nt_ = ((t0 + 3) >> 5) + 1;
  if (nt_ <= 16) select_body<16>(p, b, t0, lane, l32, h, tokbase);
  else if (nt_ <= 32) select_body<32>(p, b, t0, lane, l32, h, tokbase);
  else if (nt_ <= 48) select_body<48>(p, b, t0, lane, l32, h, tokbase);
  else select_body<64>(p, b, t0, lane, l32, h, tokbase);
}

template <int HPG, bool MASKED>
DI void attn_block(const u16* __restrict__ Q, int ldq, const u16* __restrict__ K, int ldk, const u16* __restrict__ VT, int ldv,
                   const unsigned* __restrict__ mrow, int nk64, int tok0, const u16* __restrict__ gatep, u16* __restrict__ catp,
                   char* smem) {
  int tid_ = threadIdx.x;
  asm volatile("" : "+v"(tid_));
  const int tid = tid_, lane = tid & 63, l32 = lane & 31, h = lane >> 5;
  const int tok = tok0 + l32 / HPG, hd = l32 % HPG;
  const u16* qp = Q + (long)tok * ldq + hd * 64 + 8 * h;
  bf16x8 qf[4];
#pragma unroll
  for (int kk = 0; kk < 4; ++kk) qf[kk] = *(const bf16x8*)(qp + 16 * kk);
  f32x16 o0, o1;
#pragma unroll
  for (int i = 0; i < 16; ++i) { o0[i] = 0.f; o1[i] = 0.f; }
  float m = NEG_INF, lsum = 0.f;
  const int srow = tid >> 3, scc = tid & 7;
  u32x4 rk[2], rv[2];
  u32x2 mw = {0xffffffffu, 0xffffffffu};
#define ATTN_LOAD_REGS(T)                                                                            \
  {                                                                                                  \
    const int key0_ = 64 * (T);                                                                      \
    _Pragma("unroll") for (int i = 0; i < 2; ++i) {                                                  \
      rk[i] = *(const u32x4*)(K + (long)(key0_ + srow + 32 * i) * ldk + scc * 8);                    \
      rv[i] = *(const u32x4*)(VT + (long)(srow + 32 * i) * ldv + key0_ + scc * 8);                   \
    }                                                                                                \
    if (MASKED) mw = *(const u32x2*)(mrow + (long)tok * 64 + 2 * (T));                               \
  }
#define ATTN_STORE_LDS(BUF)                                                                          \
  {                                                                                                  \
    char* kb_ = smem + (BUF) * 18432;                                                                \
    char* vb_ = kb_ + 9216;                                                                          \
    _Pragma("unroll") for (int i = 0; i < 2; ++i) {                                                  \
      *(u32x4*)(kb_ + (srow + 32 * i) * LDS_STRIDE + scc * 16) = rk[i];                              \
      *(u32x4*)(vb_ + (srow + 32 * i) * LDS_STRIDE + scc * 16) = rv[i];                              \
    }                                                                                                \
  }
  const long obase = (long)tok * 1024 + hd * 64;
  u32x2 gvv[2][4];
#pragma unroll
  for (int dt = 0; dt < 2; ++dt)
#pragma unroll
    for (int q4 = 0; q4 < 4; ++q4) gvv[dt][q4] = *(const u32x2*)(gatep + obase + 32 * dt + 8 * q4 + 4 * h);
  __syncthreads();
  ATTN_LOAD_REGS(0);
  ATTN_STORE_LDS(0);
  u32x2 mcur = mw;
  __syncthreads();
  for (int t = 0; t < nk64; ++t) {
    {
      const int tn = (t + 1 < nk64) ? t + 1 : t;
      ATTN_LOAD_REGS(tn);
    }
    __builtin_amdgcn_sched_barrier(0);
    const char* kb = smem + (t & 1) * 18432;
    const char* vb = kb + 9216;
    f32x16 sv[2];
    __builtin_amdgcn_s_setprio(1);
#pragma unroll
    for (int st = 0; st < 2; ++st) {
#pragma unroll
      for (int i = 0; i < 16; ++i) sv[st][i] = 0.f;
#pragma unroll
      for (int kk = 0; kk < 4; ++kk) {
        bf16x8 kf = *(const bf16x8*)(kb + (32 * st + l32) * LDS_STRIDE + (16 * kk + 8 * h) * 2);
        sv[st] = MFMA(kf, qf[kk], sv[st]);
      }
    }
    __builtin_amdgcn_s_setprio(0);
    float mt = NEG_INF;
#pragma unroll
    for (int st = 0; st < 2; ++st) {
      const unsigned wc = (st == 0 ? mcur.x : mcur.y) >> (4 * h);
#pragma unroll
      for (int i = 0; i < 16; ++i) {
        float x = sv[st][i];
        if (MASKED) {
          const int bi = (i & 3) + 8 * (i >> 2);
          const unsigned mm = (unsigned)__builtin_amdgcn_sbfe((int)wc, bi, 1);
          x = __uint_as_float((__float_as_uint(x) & mm) | (0xff800000u & ~mm));
        }
        sv[st][i] = x;
        mt = fmaxf(mt, x);
      }
    }
    mt = fmaxf(mt, __shfl_xor(mt, 32));
    const float mnew = fmaxf(m, mt);
    const float msafe = fmaxf(mnew, -1e30f);
    const float alpha = __builtin_amdgcn_exp2f(m - msafe);
    float ps = 0.f;
#pragma unroll
    for (int st = 0; st < 2; ++st)
#pragma unroll
      for (int i = 0; i < 16; ++i) {
        float pv = __builtin_amdgcn_exp2f(sv[st][i] - msafe);
        sv[st][i] = pv;
        ps += pv;
      }
    lsum = lsum * alpha + ps;
    m = mnew;
    if (!__all(alpha == 1.0f)) {
#pragma unroll
      for (int i = 0; i < 16; ++i) { o0[i] *= alpha; o1[i] *= alpha; }
    }
#pragma unroll
    for (int st = 0; st < 2; ++st)
#pragma unroll
      for (int ks = 0; ks < 2; ++ks) {
        u32x4 uu;
        uu.x = pack2(sv[st][8 * ks + 0], sv[st][8 * ks + 1]); uu.y = pack2(sv[st][8 * ks + 2], sv[st][8 * ks + 3]);
        uu.z = pack2(sv[st][8 * ks + 4], sv[st][8 * ks + 5]); uu.w = pack2(sv[st][8 * ks + 6], sv[st][8 * ks + 7]);
        bf16x8 pf = __builtin_bit_cast(bf16x8, uu);
#pragma unroll
        for (int dt = 0; dt < 2; ++dt) {
          const char* vp = vb + (32 * dt + l32) * LDS_STRIDE + (32 * st + 16 * ks + 4 * h) * 2;
          s16x4 a_ = *(const s16x4*)vp, c_ = *(const s16x4*)(vp + 16);
          bf16x8 vf = __builtin_shufflevector(a_, c_, 0, 1, 2, 3, 4, 5, 6, 7);
          if (dt == 0) o0 = MFMA(vf, pf, o0); else o1 = MFMA(vf, pf, o1);
        }
      }
    ATTN_STORE_LDS((t + 1) & 1);
    mcur = mw;
    __syncthreads();
  }
  lsum += __shfl_xor(lsum, 32);
  const float inv = 1.f / lsum;
#pragma unroll
  for (int dt = 0; dt < 2; ++dt)
#pragma unroll
    for (int q4 = 0; q4 < 4; ++q4) {
      int d = 32 * dt + 8 * q4 + 4 * h;
      u32x2 gv = gvv[dt][q4];
      float g0 = __uint_as_float(gv.x << 16), g1 = __uint_as_float(gv.x & 0xffff0000u);
      float g2 = __uint_as_float(gv.y << 16), g3 = __uint_as_float(gv.y & 0xffff0000u);
      float v0, v1, v2, v3;
      if (dt == 0) { v0 = o0[4 * q4]; v1 = o0[4 * q4 + 1]; v2 = o0[4 * q4 + 2]; v3 = o0[4 * q4 + 3]; }
      else { v0 = o1[4 * q4]; v1 = o1[4 * q4 + 1]; v2 = o1[4 * q4 + 2]; v3 = o1[4 * q4 + 3]; }
      u32x2 ov;
      ov.x = pack2(v0 * inv * g0, v1 * inv * g1);
      ov.y = pack2(v2 * inv * g2, v3 * inv * g3);
      *(u32x2*)(catp + obase + d) = ov;
    }
}

DI void phase2(const Params& p, char* smem, int parts = 7) {
  const int w = threadIdx.x >> 6;
  const int n_sel = 16 * 128, n_g1 = 128, n_mem = 16 * 4 * 16, n_pad = 256;
  for (int it0 = blockIdx.x; it0 < n_sel + n_mem + n_pad + n_g1; it0 += gridDim.x) {
    int it;
    if (it0 < n_sel) it = it0;
    else if (it0 < n_sel + n_mem) it = it0 + n_g1;
    else if (it0 < n_sel + n_mem + n_pad) continue;
    else it = n_sel + (it0 - n_sel - n_mem - n_pad);
    if (it < n_sel) {
      if (!(parts & 1)) continue;
      int grp = 127 - (it >> 4), b = it & 15;
      select_wave(p, b, grp * 16 + w * 4);
    } else if (it < n_sel + n_g1) {
      if (!(parts & 2)) continue;
      int id = it - n_sel, g = id >> 3, rt = (id >> 1) & 3, kh = id & 1;
      gemm_tile<false>(p.U + ((long)g * 512 + rt * 128) * UROW + kh * 512, UROW, p.E + (long)g * 128 * 1024 + kh * 512, 1024, 512, rt * 128, 0,
                       [&](int r0, int c0, const f32x16& a) {
                         const int lane = threadIdx.x & 63, l32 = lane & 31, h = lane >> 5;
                         float* dst = p.Sbuf + (long)kh * (8192 * 128) + ((long)g * 512 + r0 + l32) * 128 + c0;
#pragma unroll
                         for (int q4 = 0; q4 < 4; ++q4) {
                           f32x4 o = {a[4 * q4], a[4 * q4 + 1], a[4 * q4 + 2], a[4 * q4 + 3]};
                           *(f32x4*)(dst + 8 * q4 + 4 * h) = o;
                         }
                       }, smem);
    } else {
      if (!(parts & 4)) continue;
      int id = it - n_sel - n_g1;
      int b = id >> 6, hm = (id >> 4) & 3, tile = id & 15;
      const long tb = (long)b * SEQ;
      attn_block<1, false>(p.qm + tb * 256 + hm * 64, 256, p.mkb + (long)b * 256 * 256 + hm * 64, 256,
                           p.mvT + (long)(b * 4 + hm) * 64 * 256, 256, nullptr, 4, tile * 128 + w * 32,
                           p.gate + tb * 1024 + 768 + hm * 64, p.cat + tb * 1024 + 768 + hm * 64, smem);
    }
  }
}

DI void phase3(const Params& p, char* smem) {
  const int w = threadIdx.x >> 6;
  {
    const int gtid = blockIdx.x * 256 + threadIdx.x;
    if (gtid < 16 * 16 * 64) {
      int g = gtid >> 10, b = (gtid >> 6) & 15, pp = gtid & 63;
      float sr[32], si[32];
      const long row0 = (long)(g * 16 + b) * 32;
#pragma unroll
      for (int c = 0; c < 32; ++c) {
        sr[c] = p.Sbuf[(row0 + c) * 128 + pp] + p.Sbuf[8192 * 128 + (row0 + c) * 128 + pp];
        si[c] = p.Sbuf[(row0 + c) * 128 + 64 + pp] + p.Sbuf[8192 * 128 + (row0 + c) * 128 + 64 + pp];
      }
      double lr, li;
      lam_pow(p, g, pp, 64, lr, li);
      float ar = (float)lr, ai = (float)li;
      float xr = 0.f, xi = 0.f;
#pragma unroll
      for (int c = 0; c < 32; ++c) {
        *(unsigned*)(p.U + (row0 + c) * UROW + 1024 + 2 * pp) = pack2(xr, xi);
        float nr = ar * xr - ai * xi + sr[c];
        float ni = ar * xi + ai * xr + si[c];
        xr = nr; xi = ni;
      }
    }
  }
  const int xcd = blockIdx.x & 7, nper = gridDim.x >> 3;
  for (int j = blockIdx.x >> 3; j < 256; j += nper) {
    int tt = 63 - (j >> 2), r = j & 3, b = 2 * xcd + (r >> 1), g = r & 1;
    if (nper == 64) {
      const int q = (j >> 2) & 15, k = j >> 6;
      tt = k == 0 ? 63 - q : (k == 1 ? 32 + q : (k == 2 ? 31 - q : q));
    }
    const long tb = (long)b * SEQ;
    attn_block<4, true>(p.qb + tb * 512 + g * 256, 512, p.kb + tb * 128 + g * 64, 128, p.vT + (long)(b * 2 + g) * 64 * 2048, 2048,
                        p.mask + tb * 64, (tt >> 1) + 1, tt * 32 + w * 8, p.gate + tb * 1024 + g * 256, p.cat + tb * 1024 + g * 256, smem);
  }
}

DI void phase4(const Params& p, char* smem) {
  for (int it = vblock(); it < 16 * 4 * 8; it += gridDim.x) {
    int g = it >> 5, rt = (it >> 3) & 3, ct = it & 7;
    gemm_tile<false>(p.U + ((long)g * 512 + rt * 128) * UROW, UROW, p.W3 + ((long)g * 1024 + ct * 128) * UROW, UROW, UROW, rt * 128, ct * 128,
                     [&](int r0, int c0, const f32x16& a) {
                       const int lane = threadIdx.x & 63, l32 = lane & 31, h = lane >> 5;
                       const int row = r0 + l32, b = row >> 5, c = row & 31;
#pragma unroll
                       for (int q4 = 0; q4 < 4; ++q4) {
                         int f = c0 + 8 * q4 + 4 * h, t = f >> 4, n0 = f & 15;
                         long tok = (long)b * SEQ + c * 64 + t;
                         *(u32x2*)(p.yact + tok * 256 + g * 16 + n0) =
                             pack4(gelu_tanh(a[4 * q4]), gelu_tanh(a[4 * q4 + 1]), gelu_tanh(a[4 * q4 + 2]), gelu_tanh(a[4 * q4 + 3]));
                       }
                     }, smem);
  }
}

DI void phase5(const Params& p, char* smem) {
  for (int it = vblock(); it < 256 * 2; it += gridDim.x) {
    int rt = it >> 1, ct = it & 1;
    gemm_tile<false>(p.yact + (long)rt * 128 * 256, 256, p.wgluT + (long)ct * 128 * 256, 256, 256, rt * 128, ct * 128,
                     [&](int r0, int c0, const f32x16& a) {
                       const int lane = threadIdx.x & 63, l32 = lane & 31, h = lane >> 5;
                       const long row = r0 + l32;
                       f32x4 bg[4];
                       u32x2 yv[4], gv[4];
#pragma unroll
                       for (int q4 = 0; q4 < 4; ++q4) {
                         int col = c0 + 8 * q4 + 4 * h;
                         bg[q4] = *(const f32x4*)(p.b_glu + col);
                         yv[q4] = *(const u32x2*)(p.yact + row * 256 + col);
                         gv[q4] = *(const u32x2*)(p.gate + row * 1024 + 512 + col);
                       }
#pragma unroll
                       for (int q4 = 0; q4 < 4; ++q4) {
                         int col = c0 + 8 * q4 + 4 * h;
                         float y4[4] = {bflo(yv[q4].x), bfhi(yv[q4].x), bflo(yv[q4].y), bfhi(yv[q4].y)};
                         float g4[4] = {bflo(gv[q4].x), bfhi(gv[q4].x), bflo(gv[q4].y), bfhi(gv[q4].y)};
                         float b4[4] = {bg[q4].x, bg[q4].y, bg[q4].z, bg[q4].w};
                         float o[4];
#pragma unroll
                         for (int e = 0; e < 4; ++e) {
                           float v = a[4 * q4 + e] + b4[e];
                           float sg = 1.f / (1.f + __expf(-v));
                           o[e] = y4[e] * sg * g4[e];
                         }
                         *(u32x2*)(p.cat + row * 1024 + 512 + col) = pack4(o[0], o[1], o[2], o[3]);
                       }
                     }, smem);
  }
}

DI void phase6(const Params& p, char* smem) {
  for (int it = vblock(); it < 128 * 8; it += gridDim.x) {
    int rt = it >> 3, ct = it & 7;
    gemm_big_ln(p, p.cat + (long)rt * 256 * 1024, 1024, p.woutT + (long)ct * 128 * 1024, 1024, 1024, rt, ct, smem);
  }
}

DI void phase7(const Params& p) {
  const int lane = threadIdx.x & 63, w = threadIdx.x >> 6;
  const int stride = gridDim.x * 4;
  int row = blockIdx.x * 4 + w;
  if (row >= NTOK) return;
  f32x4 gv[4], bv[4];
#pragma unroll
  for (int i = 0; i < 4; ++i) { gv[i] = ((const f32x4*)p.ln_g)[lane + 64 * i]; bv[i] = ((const f32x4*)p.ln_b)[lane + 64 * i]; }
  f32x4 v[4], vn[4];
#pragma unroll
  for (int i = 0; i < 4; ++i) v[i] = ((const f32x4*)(p.out + (long)row * 1024))[lane + 64 * i];
  for (; row < NTOK; row += stride) {
    const int nrow = (row + stride < NTOK) ? row + stride : row;
#pragma unroll
    for (int i = 0; i < 4; ++i) vn[i] = ((const f32x4*)(p.out + (long)nrow * 1024))[lane + 64 * i];
    float s = 0.f;
#pragma unroll
    for (int i = 0; i < 4; ++i) s += (v[i].x + v[i].y) + (v[i].z + v[i].w);
#pragma unroll
    for (int o = 32; o >= 1; o >>= 1) s += __shfl_xor(s, o);
    float mu = s * (1.f / 1024.f);
    float q = 0.f;
#pragma unroll
    for (int i = 0; i < 4; ++i) {
      float a = v[i].x - mu, b = v[i].y - mu, c = v[i].z - mu, d = v[i].w - mu;
      q += (a * a + b * b) + (c * c + d * d);
    }
#pragma unroll
    for (int o = 32; o >= 1; o >>= 1) q += __shfl_xor(q, o);
    float rs = rsqrtf(q * (1.f / 1024.f) + 1e-5f);
    f32x4* rp = (f32x4*)(p.out + (long)row * 1024);
#pragma unroll
    for (int i = 0; i < 4; ++i) {
      f32x4 o;
      o.x = (v[i].x - mu) * rs * gv[i].x + bv[i].x;
      o.y = (v[i].y - mu) * rs * gv[i].y + bv[i].y;
      o.z = (v[i].z - mu) * rs * gv[i].z + bv[i].z;
      o.w = (v[i].w - mu) * rs * gv[i].w + bv[i].w;
      rp[lane + 64 * i] = o;
    }
#pragma unroll
    for (int i = 0; i < 4; ++i) v[i] = vn[i];
  }
}


#define XB_TMO      128
#define XB_XCNT(j)  (256  + 64 * (j))
#define XB_XSUB(j)  (1280 + 64 * (j))
#define XB_XGEN(j)  (2304 + 64 * (j))
#define XB_TOP      3328
#define XB_TOPGEN   3392
#define XCD_BAR_WORDS 3456
#define XB_SPIN_CAP (1u << 18)
#define LAS __attribute__((address_space(3)))

DI unsigned xb_ld(unsigned* p) { return __hip_atomic_load(p, __ATOMIC_RELAXED, __HIP_MEMORY_SCOPE_AGENT); }
DI unsigned xb_add(unsigned* p, unsigned v) { return __hip_atomic_fetch_add(p, v, __ATOMIC_RELAXED, __HIP_MEMORY_SCOPE_AGENT); }
DI unsigned xb_xcc_id() { return (unsigned)__builtin_amdgcn_s_getreg((3 << 11) | 20) & 0xFu; }
#define XB_SPIN(cond, bar) do { unsigned _sp = 0; while (cond) { __builtin_amdgcn_s_sleep(1); \
    if ((++_sp & 255u) == 0u) { if (xb_ld(&(bar)[XB_TMO])) break; if (_sp > XB_SPIN_CAP) { atomicAdd(&(bar)[XB_TMO], 1u); break; } } } } while (0)

struct XcdBarrier { unsigned* bar; unsigned x; volatile LAS unsigned* st; };

DI XcdBarrier xcd_barrier_post(unsigned* bar, volatile LAS unsigned* st) {
  XcdBarrier b; b.bar = bar; b.x = xb_xcc_id(); b.st = st;
  if (threadIdx.x == 0) (void)xb_add(&bar[XB_XCNT(b.x)], 1u);
  return b;
}
DI void xcd_barrier_complete(unsigned* bar, unsigned x, unsigned& nloc, unsigned& nx) {
  const unsigned G = gridDim.x * gridDim.y * gridDim.z;
  unsigned sum, cnt, mine, sp = 0u;
  for (;;) {
    sum = 0u; cnt = 0u; mine = 0u;
#pragma unroll
    for (unsigned j = 0; j < 16; ++j) { const unsigned c = xb_ld(&bar[XB_XCNT(j)]); sum += c; cnt += (c > 0u) ? 1u : 0u; mine = (j == x) ? c : mine; }
    if (sum == G) break;
    __builtin_amdgcn_s_sleep(1);
    if ((++sp & 255u) == 0u) { if (xb_ld(&bar[XB_TMO])) break; if (sp > XB_SPIN_CAP) { atomicAdd(&bar[XB_TMO], 1u); break; } }
  }
  nloc = mine > 0u ? mine : 1u; nx = cnt > 0u ? cnt : 1u;
}
DI void xcd_barrier(const XcdBarrier& b) {
  asm volatile("s_waitcnt vmcnt(0)" ::: "memory");
  __syncthreads();
  if (threadIdx.x == 0) {
    unsigned* bar = b.bar;
    __builtin_amdgcn_s_waitcnt(0);
    unsigned nloc = b.st[0], nx = b.st[1];
    if (nloc == 0u) { xcd_barrier_complete(bar, b.x, nloc, nx); b.st[0] = nloc; b.st[1] = nx; }
    const unsigned old = xb_add(&bar[XB_XSUB(b.x)], 1u);
    const unsigned gen = old / nloc;
    if (old + 1u == (gen + 1u) * nloc) {
      __builtin_amdgcn_fence(__ATOMIC_RELEASE, "agent");
      asm volatile("s_waitcnt vmcnt(0)" ::: "memory");
      const unsigned og = xb_add(&bar[XB_TOP], 1u);
      const unsigned tg = og / nx;
      if (og + 1u == (tg + 1u) * nx) xb_add(&bar[XB_TOPGEN], 1u);
      else XB_SPIN(xb_ld(&bar[XB_TOPGEN]) == tg, bar);
      __builtin_amdgcn_fence(__ATOMIC_ACQUIRE, "agent");
      xb_add(&bar[XB_XGEN(b.x)], 1u);
      asm volatile("s_waitcnt vmcnt(0)" ::: "memory");
    } else {
      XB_SPIN(xb_ld(&bar[XB_XGEN(b.x)]) == gen, bar);
      __builtin_amdgcn_fence(__ATOMIC_ACQUIRE, "agent");
      asm volatile("s_waitcnt vmcnt(0)" ::: "memory");
    }
  }
  __syncthreads();
}

__global__ void __launch_bounds__(256, 2) mega(Params p, int ph0, int ph1) {
  __shared__ __attribute__((aligned(16))) char smem[SMEM_BYTES];
  cg::grid_group grid = cg::this_grid();
  __shared__ uint4 xb_words;
  if (threadIdx.x == 0) xb_words = make_uint4(0u, 0u, 0u, 0u);
  __syncthreads();
  XcdBarrier xb = xcd_barrier_post(p.bar, (volatile LAS unsigned*)&xb_words);
  if (ph0 < 0) grid.sync();
#define GRID_SYNC() xcd_barrier(xb)
#ifndef DUP_MASK
#define DUP_MASK 0
#endif
#define RUN_PHASE(N, CALL)                          \
  if (ph0 <= N && N < ph1) {                       \
    CALL;                                          \
    if ((DUP_MASK >> N) & 1) { GRID_SYNC(); CALL; } \
    if (N + 1 < ph1) GRID_SYNC();                  \
  }
  RUN_PHASE(0, phase0(p, smem))
  RUN_PHASE(1, phase1(p, smem))
  RUN_PHASE(2, phase2(p, smem))
  if ((DUP_MASK >> 8) & 7) { GRID_SYNC(); phase2(p, smem, (DUP_MASK >> 8) & 7); GRID_SYNC(); }
  RUN_PHASE(3, phase3(p, smem))
  RUN_PHASE(4, phase4(p, smem))
  RUN_PHASE(5, phase5(p, smem))
  RUN_PHASE(6, phase6(p, smem))
  if ((DUP_MASK >> 12) & 1) { for (int i = 0; i < 8; ++i) GRID_SYNC(); }
  if ((DUP_MASK >> 13) & 3) {
    GRID_SYNC();
    for (int it = vblock(); it < 128 * 21; it += gridDim.x) {
      int rt = it / 21, ct = it % 21;
      if ((DUP_MASK >> 13) & 1) { rt = 0; ct = 0; }
      gemm_big(p.xb + (long)rt * 256 * 1024, 1024, p.winT + (long)ct * 128 * 1024, 1024, 1024, 0, 0,
               [&](int r0, int c0, const f32x16& a) {
                 const int lane = threadIdx.x & 63, l32 = lane & 31, h = lane >> 5;
#pragma unroll
                 for (int q4 = 0; q4 < 4; ++q4) *(u32x2*)(p.scratch + (long)(r0 + l32) * 128 + c0 + 8 * q4 + 4 * h) = pack4(a[4 * q4], a[4 * q4 + 1], a[4 * q4 + 2], a[4 * q4 + 3]);
               }, smem);
    }
  }
}

extern "C" void kernel_launch(void* const* d_in, const int* in_sizes, int n_in, void* d_out, int out_size, void* d_ws,
                              size_t ws_size, hipStream_t stream) {
  static int grid_blocks = 0;
  if (!grid_blocks) {
    int dev = 0, cus = 0, per_cu = 0;
    hipGetDevice(&dev);
    hipDeviceGetAttribute(&cus, hipDeviceAttributeMultiprocessorCount, dev);
    hipOccupancyMaxActiveBlocksPerMultiprocessor(&per_cu, mega, 256, 0);
    if (per_cu < 1) per_cu = 1;
    if (per_cu > 2) per_cu = 2;
    grid_blocks = cus * per_cu;
  }
  Params p{};
  p.x = (const float*)d_in[0]; p.mem = (const float*)d_in[1]; p.w_in = (const float*)d_in[2]; p.w_mem_kv = (const float*)d_in[3];
  p.lam_re = (const float*)d_in[4]; p.lam_im = (const float*)d_in[5]; p.log_dt = (const float*)d_in[6];
  p.b_re = (const float*)d_in[7]; p.b_im = (const float*)d_in[8]; p.c_re = (const float*)d_in[9]; p.c_im = (const float*)d_in[10];
  p.d_skip = (const float*)d_in[11]; p.w_glu = (const float*)d_in[12]; p.b_glu = (const float*)d_in[13];
  p.w_out = (const float*)d_in[14]; p.ln_g = (const float*)d_in[15]; p.ln_b = (const float*)d_in[16];
  p.out = (float*)d_out;
  char* ws = (char*)d_ws;
  size_t off = 0;
  auto take = [&](size_t bytes) { char* r = ws + off; off += (bytes + 255) & ~(size_t)255; return r; };
  p.winT = (u16*)take((size_t)NZ * 1024 * 2);
  p.woutT = (u16*)take((size_t)1024 * 1024 * 2);
  p.wmemT = (u16*)take((size_t)512 * 1024 * 2);
  p.wgluT = (u16*)take((size_t)256 * 256 * 2);
  p.qb = (u16*)take((size_t)NTOK * 512 * 2);
  p.kb = (u16*)take((size_t)NTOK * 128 * 2);
  p.vT = (u16*)take((size_t)NTOK * 128 * 2);
  p.qib = (u16*)take((size_t)NTOK * 256 * 2);
  p.kib = (u16*)take((size_t)NTOK * 32 * 2);
  p.gate = (u16*)take((size_t)NTOK * 1024 * 2);
  p.qm = (u16*)take((size_t)NTOK * 256 * 2);
  p.U = (u16*)take((size_t)8192 * UROW * 2);
  p.mkb = (u16*)take((size_t)4096 * 256 * 2);
  p.mvT = (u16*)take((size_t)4096 * 256 * 2);
  p.E = (u16*)take((size_t)16 * 128 * 1024 * 2);
  p.W3 = (u16*)take((size_t)16 * 1024 * UROW * 2);
  p.yact = (u16*)take((size_t)NTOK * 256 * 2);
  p.cat = (u16*)take((size_t)NTOK * 1024 * 2);
  p.wi = (float*)take((size_t)NTOK * 8 * 4);
  p.Sbuf = (float*)take((size_t)2 * 8192 * 128 * 4);
  p.kern = (float*)take((size_t)16 * 64 * 256 * 4);
  p.mask = (unsigned*)take((size_t)NTOK * 64 * 4);
  p.rope = (float2*)take((size_t)2048 * 8 * 8);
  p.bar = (unsigned*)take((size_t)(XCD_BAR_WORDS + 4608) * 4);
  p.ctr = p.bar + XCD_BAR_WORDS;
  hipMemsetAsync(p.bar, 0, (size_t)(XCD_BAR_WORDS + 4608) * 4, stream);
  p.xb = (u16*)take((size_t)NTOK * 1024 * 2);
  p.scratch = (u16*)take((size_t)256 * 128 * 2);
  p.lnst = (float2*)take((size_t)128 * 8 * 256 * 8);
  int ph0 = 0, ph1 = 7;
  void* args[] = {&p, &ph0, &ph1};
  hipError_t e = hipLaunchCooperativeKernel((void*)mega, dim3(grid_blocks), dim3(256), args, 0, stream);
  if (e != hipSuccess) fprintf(stderr, "cooperative launch failed: %s (grid %d)\n", hipGetErrorString(e), grid_blocks);
}
```

```cpp
#include <hip/hip_runtime.h>
#include <hip/hip_cooperative_groups.h>
#include <cstdio>
namespace cg = cooperative_groups;

typedef unsigned short u16;
typedef __attribute__((ext_vector_type(8))) short bf16x8;
typedef __attribute__((ext_vector_type(4))) short s16x4;
typedef __attribute__((ext_vector_type(16))) float f32x16;
typedef __attribute__((ext_vector_type(2))) float f32x2;
typedef __attribute__((ext_vector_type(4))) float f32x4;
typedef __attribute__((ext_vector_type(4))) unsigned u32x4;
typedef __attribute__((ext_vector_type(2))) unsigned u32x2;
typedef __attribute__((ext_vector_type(2))) __bf16 bf16x2;

#define DI __device__ __forceinline__
#define MFMA(a, b, c) __builtin_amdgcn_mfma_f32_32x32x16_bf16((a), (b), (c), 0, 0, 0)

constexpr int NB = 16, SEQ = 2048, DM = 1024, NTOK = NB * SEQ;
constexpr int NZ = 2688;
constexpr int UROW = 1152;
constexpr int LDS_STRIDE = 144;
constexpr int SMEM_BYTES = (256 + 128) * LDS_STRIDE;
constexpr float NEG_INF = -__builtin_huge_valf();
constexpr float QSCALE = 0.125f * 1.4426950408889634f;

struct Params {
  const float *x, *mem, *w_in, *w_mem_kv, *lam_re, *lam_im, *log_dt, *b_re, *b_im, *c_re, *c_im, *d_skip,
      *w_glu, *b_glu, *w_out, *ln_g, *ln_b;
  float* out;
  u16 *winT, *woutT, *wmemT, *wgluT, *qb, *kb, *vT, *qib, *kib, *gate, *qm, *U, *mkb, *mvT, *E, *W3, *yact, *cat;
  float *wi, *Sbuf, *kern;
  float2* rope;
  u16* xb;
  u16* scratch;
  unsigned* mask;
  unsigned* bar;
  unsigned* ctr;
  float2* lnst;
};

__constant__ float c_inv8[8] = {1.0f, 0.19392274474868576f, 0.03760603093086393f, 0.007292664737217109f,
                                0.001414213562373095f, 0.0002742481756762073f, 5.318295896944988e-05f,
                                1.031338537721246e-05f};

DI unsigned pack2(float a, float b) {
  f32x2 v = {a, b};
  bf16x2 r = __builtin_convertvector(v, bf16x2);
  return __builtin_bit_cast(unsigned, r);
}
DI u16 f2bf(float a) { return (u16)(pack2(a, 0.f) & 0xffffu); }
DI float bf2f(u16 v) { return __uint_as_float(((unsigned)v) << 16); }
DI unsigned xb_add(unsigned* p, unsigned v);
DI unsigned xb_ld(unsigned* p);
DI int crow(int i, int h) { return (i & 3) + 8 * (i >> 2) + 4 * h; }
DI u32x2 pack4(float a, float b, float c, float d) { u32x2 r; r.x = pack2(a, b); r.y = pack2(c, d); return r; }
DI float bflo(unsigned u) { return __uint_as_float(u << 16); }
DI float bfhi(unsigned u) { return __uint_as_float(u & 0xffff0000u); }
DI float silu(float v) { return v / (1.f + __expf(-v)); }
DI float gelu_tanh(float v) {
  float u = 0.7978845608028654f * (v + 0.044715f * v * v * v);
  float e = __expf(-2.f * fabsf(u));
  float t = (1.f - e) / (1.f + e);
  t = u < 0.f ? -t : t;
  return 0.5f * v * (1.f + t);
}

DI void sincos_rev(double rev, double& c, double& s) {
  rev -= rint(rev);
  double q = rint(rev * 4.0);
  double r = (rev - q * 0.25) * 6.283185307179586476925;
  double r2 = r * r;
  double sp = r * (1.0 + r2 * (-1.0 / 6 + r2 * (1.0 / 120 + r2 * (-1.0 / 5040 + r2 * (1.0 / 362880 + r2 * (-1.0 / 39916800 + r2 * (1.0 / 6227020800.0)))))));
  double cp = 1.0 + r2 * (-0.5 + r2 * (1.0 / 24 + r2 * (-1.0 / 720 + r2 * (1.0 / 40320 + r2 * (-1.0 / 3628800 + r2 * (1.0 / 479001600.0 + r2 * (-1.0 / 87178291200.0)))))));
  int qi = ((int)q) & 3;
  if (qi == 0) { c = cp; s = sp; }
  else if (qi == 1) { c = -sp; s = cp; }
  else if (qi == 2) { c = -cp; s = -sp; }
  else { c = sp; s = -cp; }
}
DI void lam_pow(const Params& p, int g, int pp, int j, double& re, double& im) {
  double dt = exp((double)p.log_dt[g]);
  double lr = p.lam_re[g * 64 + pp], li = p.lam_im[g * 64 + pp];
  double mag = exp(lr * dt * (double)j);
  double c, s;
  sincos_rev(li * dt * (double)j * 0.15915494309189533577, c, s);
  re = mag * c; im = mag * s;
}
DI void zoh_factor(const Params& p, int g, int pp, double& fr, double& fi) {
  double lbr, lbi;
  lam_pow(p, g, pp, 1, lbr, lbi);
  double lr = p.lam_re[g * 64 + pp], li = p.lam_im[g * 64 + pp];
  double nr = lbr - 1.0, ni = lbi;
  double den = lr * lr + li * li;
  fr = (nr * lr + ni * li) / den;
  fi = (ni * lr - nr * li) / den;
}

template <bool A_F32, class Epi>
DI void gemm_tile(const void* Aptr, long lda, const u16* Bt, long ldb, int K, int rowbase, int colbase, Epi epi, char* smem) {
  int tid_ = threadIdx.x;
  asm volatile("" : "+v"(tid_));
  const int tid = tid_, lane = tid & 63, w = tid >> 6, wm = w >> 1, wn = w & 1, l32 = lane & 31, h = lane >> 5;
  char* sA = smem;
  char* sB = smem + 128 * LDS_STRIDE;
  f32x16 acc[2][2];
#pragma unroll
  for (int a = 0; a < 2; ++a)
#pragma unroll
    for (int b = 0; b < 2; ++b)
#pragma unroll
      for (int i = 0; i < 16; ++i) acc[a][b][i] = 0.f;

  f32x4 raf[A_F32 ? 8 : 1];
  u32x4 rab[A_F32 ? 1 : 4];
  u32x4 rb[4];

#define GEMM_LOAD_REGS(K0)                                                                      \
  {                                                                                             \
    if constexpr (A_F32) {                                                                      \
      const float* A_ = (const float*)Aptr;                                                     \
      _Pragma("unroll") for (int i = 0; i < 8; ++i) {                                           \
        int id = tid + 256 * i, row = id >> 4, cc = id & 15;                                    \
        raf[i] = *(const f32x4*)(A_ + (long)row * lda + (K0) + cc * 4);                        \
      }                                                                                         \
    } else {                                                                                    \
      const u16* A_ = (const u16*)Aptr;                                                         \
      _Pragma("unroll") for (int i = 0; i < 4; ++i) {                                           \
        int id = tid + 256 * i, row = id >> 3, cc = id & 7;                                     \
        rab[i] = *(const u32x4*)(A_ + (long)row * lda + (K0) + cc * 8);                         \
      }                                                                                         \
    }                                                                                           \
    _Pragma("unroll") for (int i = 0; i < 4; ++i) {                                             \
      int id = tid + 256 * i, row = id >> 3, cc = id & 7;                                       \
      rb[i] = *(const u32x4*)(Bt + (long)row * ldb + (K0) + cc * 8);                            \
    }                                                                                           \
  }
#define GEMM_STORE_LDS()                                                                        \
  {                                                                                             \
    if constexpr (A_F32) {                                                                      \
      _Pragma("unroll") for (int i = 0; i < 8; ++i) {                                           \
        int id = tid + 256 * i, row = id >> 4, cc = id & 15;                                    \
        u32x2 v;                                                                                \
        v.x = pack2(raf[i].x, raf[i].y);                                                        \
        v.y = pack2(raf[i].z, raf[i].w);                                                        \
        *(u32x2*)(sA + row * LDS_STRIDE + cc * 8) = v;                                          \
      }                                                                                         \
    } else {                                                                                    \
      _Pragma("unroll") for (int i = 0; i < 4; ++i) {                                           \
        int id = tid + 256 * i, row = id >> 3, cc = id & 7;                                     \
        *(u32x4*)(sA + row * LDS_STRIDE + cc * 16) = rab[i];                                    \
      }                                                                                         \
    }                                                                                           \
    _Pragma("unroll") for (int i = 0; i < 4; ++i) {                                             \
      int id = tid + 256 * i, row = id >> 3, cc = id & 7;                                       \
      *(u32x4*)(sB + row * LDS_STRIDE + cc * 16) = rb[i];                                       \
    }                                                                                           \
  }

  GEMM_LOAD_REGS(0);
  for (int k0 = 0; k0 < K; k0 += 64) {
    __syncthreads();
    GEMM_STORE_LDS();
    __syncthreads();
    if (k0 + 64 < K) GEMM_LOAD_REGS(k0 + 64);
    __builtin_amdgcn_sched_barrier(0);
#pragma unroll
    for (int ks = 0; ks < 4; ++ks) {
      bf16x8 af[2], bfr[2];
#pragma unroll
      for (int mi = 0; mi < 2; ++mi)
        af[mi] = *(const bf16x8*)(sA + (64 * wm + 32 * mi + l32) * LDS_STRIDE + (16 * ks + 8 * h) * 2);
#pragma unroll
      for (int ni = 0; ni < 2; ++ni)
        bfr[ni] = *(const bf16x8*)(sB + (64 * wn + 32 * ni + l32) * LDS_STRIDE + (16 * ks + 8 * h) * 2);
#pragma unroll
      for (int mi = 0; mi < 2; ++mi)
#pragma unroll
        for (int ni = 0; ni < 2; ++ni) acc[mi][ni] = MFMA(bfr[ni], af[mi], acc[mi][ni]);
    }
  }
#pragma unroll 1
  for (int t4 = 0; t4 < 4; ++t4) {
    f32x16 a;
#pragma unroll
    for (int i = 0; i < 16; ++i) {
      float lo = (t4 & 1) ? acc[0][1][i] : acc[0][0][i];
      float hi = (t4 & 1) ? acc[1][1][i] : acc[1][0][i];
      a[i] = (t4 & 2) ? hi : lo;
    }
    epi(rowbase + 64 * wm + 32 * (t4 >> 1), colbase + 64 * wn + 32 * (t4 & 1), a);
  }
}

template <class Epi>
DI void gemm_big(const u16* A, long lda, const u16* Bt, long ldb, int K, int rowbase, int colbase, Epi epi, char* smem) {
  int tid_ = threadIdx.x;
  asm volatile("" : "+v"(tid_));
  const int tid = tid_, lane = tid & 63, w = tid >> 6, wm = w >> 1, wn = w & 1, l32 = lane & 31, h = lane >> 5;
  char* sA = smem;
  char* sB = smem + 256 * LDS_STRIDE;
  f32x16 acc[4][2];
#pragma unroll
  for (int a = 0; a < 4; ++a)
#pragma unroll
    for (int b = 0; b < 2; ++b)
#pragma unroll
      for (int i = 0; i < 16; ++i) acc[a][b][i] = 0.f;
  u32x4 ra[8], rb[4];
  const int srow = tid >> 3, scc = tid & 7;
#define BIG_LOAD_REGS(K0)                                                                        \
  {                                                                                              \
    _Pragma("unroll") for (int i = 0; i < 8; ++i)                                                \
      ra[i] = *(const u32x4*)(A + (long)(srow + 32 * i) * lda + (K0) + scc * 8);                 \
    _Pragma("unroll") for (int i = 0; i < 4; ++i)                                                \
      rb[i] = *(const u32x4*)(Bt + (long)(srow + 32 * i) * ldb + (K0) + scc * 8);                \
  }
#define BIG_STORE_LDS()                                                                          \
  {                                                                                              \
    _Pragma("unroll") for (int i = 0; i < 8; ++i)                                                \
      *(u32x4*)(sA + (srow + 32 * i) * LDS_STRIDE + scc * 16) = ra[i];                           \
    _Pragma("unroll") for (int i = 0; i < 4; ++i)                                                \
      *(u32x4*)(sB + (srow + 32 * i) * LDS_STRIDE + scc * 16) = rb[i];                           \
  }
  BIG_LOAD_REGS(0);
  for (int k0 = 0; k0 < K; k0 += 64) {
    __syncthreads();
    BIG_STORE_LDS();
    __syncthreads();
    if (k0 + 64 < K) BIG_LOAD_REGS(k0 + 64);
    __builtin_amdgcn_sched_barrier(0);
    __builtin_amdgcn_s_setprio(1);
#pragma unroll
    for (int ks = 0; ks < 4; ++ks) {
      bf16x8 bfr[2];
#pragma unroll
      for (int ni = 0; ni < 2; ++ni)
        bfr[ni] = *(const bf16x8*)(sB + (64 * wn + 32 * ni + l32) * LDS_STRIDE + (16 * ks + 8 * h) * 2);
#pragma unroll
      for (int mi = 0; mi < 4; ++mi) {
        bf16x8 af = *(const bf16x8*)(sA + (128 * wm + 32 * mi + l32) * LDS_STRIDE + (16 * ks + 8 * h) * 2);
#pragma unroll
        for (int ni = 0; ni < 2; ++ni) acc[mi][ni] = MFMA(bfr[ni], af, acc[mi][ni]);
      }
    }
    __builtin_amdgcn_s_setprio(0);
  }
#pragma unroll 1
  for (int t8 = 0; t8 < 8; ++t8) {
    f32x16 a;
#pragma unroll
    for (int i = 0; i < 16; ++i) {
      float v0 = (t8 & 1) ? acc[0][1][i] : acc[0][0][i];
      float v1 = (t8 & 1) ? acc[1][1][i] : acc[1][0][i];
      float v2 = (t8 & 1) ? acc[2][1][i] : acc[2][0][i];
      float v3 = (t8 & 1) ? acc[3][1][i] : acc[3][0][i];
      float lo = (t8 & 2) ? v1 : v0;
      float hi = (t8 & 2) ? v3 : v2;
      a[i] = (t8 & 4) ? hi : lo;
    }
    epi(rowbase + 128 * wm + 32 * (t8 >> 1), colbase + 64 * wn + 32 * (t8 & 1), a);
  }
}

template <class TileFn, class Epi>
DI void gemm_big_stream(const u16* Abase, const u16* Bbase, int first, int step, int limit, TileFn tile_of, Epi epi, char* smem) {
  if (first >= limit) return;
  int tid_ = threadIdx.x;
  asm volatile("" : "+v"(tid_));
  const int tid = tid_, lane = tid & 63, w = tid >> 6, wm = w >> 1, wn = w & 1, l32 = lane & 31, h = lane >> 5;
  char* sA = smem;
  char* sB = smem + 256 * LDS_STRIDE;
  u32x4 ra[8], rb[4];
  const int srow = tid >> 3, scc = tid & 7;
#define STRM_LOAD_REGS(AP, BP, K0)                                                               \
  {                                                                                              \
    _Pragma("unroll") for (int i = 0; i < 8; ++i)                                                \
      ra[i] = *(const u32x4*)((AP) + (long)(srow + 32 * i) * 1024 + (K0) + scc * 8);             \
    _Pragma("unroll") for (int i = 0; i < 4; ++i)                                                \
      rb[i] = *(const u32x4*)((BP) + (long)(srow + 32 * i) * 1024 + (K0) + scc * 8);             \
  }
  int it = first, rt, ct;
  tile_of(it, rt, ct);
  const u16* A = Abase + (long)rt * 256 * 1024;
  const u16* Bt = Bbase + (long)ct * 128 * 1024;
  STRM_LOAD_REGS(A, Bt, 0);
  for (;;) {
    f32x16 acc[4][2];
#pragma unroll
    for (int a = 0; a < 4; ++a)
#pragma unroll
      for (int b = 0; b < 2; ++b)
#pragma unroll
        for (int i = 0; i < 16; ++i) acc[a][b][i] = 0.f;
    const int itn = it + step;
    const bool has_next = itn < limit;
    int rtn = rt, ctn = ct;
    if (has_next) tile_of(itn, rtn, ctn);
    const u16* An = Abase + (long)rtn * 256 * 1024;
    const u16* Btn = Bbase + (long)ctn * 128 * 1024;
    for (int k0 = 0; k0 < 1024; k0 += 64) {
      __syncthreads();
      BIG_STORE_LDS();
      __syncthreads();
      {
        const bool last = (k0 + 64 >= 1024);
        const u16* ap = last ? An : A;
        const u16* bp = last ? Btn : Bt;
        const int kn = last ? 0 : k0 + 64;
        STRM_LOAD_REGS(ap, bp, kn);
      }
      __builtin_amdgcn_sched_barrier(0);
      __builtin_amdgcn_s_setprio(1);
#pragma unroll
      for (int ks = 0; ks < 4; ++ks) {
        bf16x8 bfr[2];
#pragma unroll
        for (int ni = 0; ni < 2; ++ni)
          bfr[ni] = *(const bf16x8*)(sB + (64 * wn + 32 * ni + l32) * LDS_STRIDE + (16 * ks + 8 * h) * 2);
#pragma unroll
        for (int mi = 0; mi < 4; ++mi) {
          bf16x8 af = *(const bf16x8*)(sA + (128 * wm + 32 * mi + l32) * LDS_STRIDE + (16 * ks + 8 * h) * 2);
#pragma unroll
          for (int ni = 0; ni < 2; ++ni) acc[mi][ni] = MFMA(bfr[ni], af, acc[mi][ni]);
        }
      }
      __builtin_amdgcn_s_setprio(0);
    }
#pragma unroll 1
    for (int t8 = 0; t8 < 8; ++t8) {
      f32x16 a;
#pragma unroll
      for (int i = 0; i < 16; ++i) {
        float v0 = (t8 & 1) ? acc[0][1][i] : acc[0][0][i];
        float v1 = (t8 & 1) ? acc[1][1][i] : acc[1][0][i];
        float v2 = (t8 & 1) ? acc[2][1][i] : acc[2][0][i];
        float v3 = (t8 & 1) ? acc[3][1][i] : acc[3][0][i];
        float lo = (t8 & 2) ? v1 : v0;
        float hi = (t8 & 2) ? v3 : v2;
        a[i] = (t8 & 4) ? hi : lo;
      }
      epi(rt * 256 + 128 * wm + 32 * (t8 >> 1), ct * 128 + 64 * wn + 32 * (t8 & 1), a);
    }
    if (!has_next) break;
    it = itn; rt = rtn; ct = ctn; A = An; Bt = Btn;
  }
}

DI void gemm_big_ln(const Params& p, const u16* A, long lda, const u16* Bt, long ldb, int K, int rt, int ct, char* smem) {
  const int rowbase = rt * 256, colbase = ct * 128;
  int tid_ = threadIdx.x;
  asm volatile("" : "+v"(tid_));
  const int tid = tid_, lane = tid & 63, w = tid >> 6, wm = w >> 1, wn = w & 1, l32 = lane & 31, h = lane >> 5;
  char* sA = smem;
  char* sB = smem + 256 * LDS_STRIDE;
  f32x16 acc[4][2];
#pragma unroll
  for (int a = 0; a < 4; ++a)
#pragma unroll
    for (int b = 0; b < 2; ++b)
#pragma unroll
      for (int i = 0; i < 16; ++i) acc[a][b][i] = 0.f;
  u32x4 ra[8], rb[4];
  const int srow = tid >> 3, scc = tid & 7;
#define BIG_LOAD_REGS(K0)                                                                        \
  {                                                                                              \
    _Pragma("unroll") for (int i = 0; i < 8; ++i)                                                \
      ra[i] = *(const u32x4*)(A + (long)(srow + 32 * i) * lda + (K0) + scc * 8);                 \
    _Pragma("unroll") for (int i = 0; i < 4; ++i)                                                \
      rb[i] = *(const u32x4*)(Bt + (long)(srow + 32 * i) * ldb + (K0) + scc * 8);                \
  }
#define BIG_STORE_LDS()                                                                          \
  {                                                                                              \
    _Pragma("unroll") for (int i = 0; i < 8; ++i)                                                \
      *(u32x4*)(sA + (srow + 32 * i) * LDS_STRIDE + scc * 16) = ra[i];                           \
    _Pragma("unroll") for (int i = 0; i < 4; ++i)                                                \
      *(u32x4*)(sB + (srow + 32 * i) * LDS_STRIDE + scc * 16) = rb[i];                           \
  }
  BIG_LOAD_REGS(0);
  for (int k0 = 0; k0 < K; k0 += 64) {
    __syncthreads();
    BIG_STORE_LDS();
    __syncthreads();
    if (k0 + 64 < K) BIG_LOAD_REGS(k0 + 64);
    __builtin_amdgcn_sched_barrier(0);
    __builtin_amdgcn_s_setprio(1);
#pragma unroll
    for (int ks = 0; ks < 4; ++ks) {
      bf16x8 bfr[2];
#pragma unroll
      for (int ni = 0; ni < 2; ++ni)
        bfr[ni] = *(const bf16x8*)(sB + (64 * wn + 32 * ni + l32) * LDS_STRIDE + (16 * ks + 8 * h) * 2);
#pragma unroll
      for (int mi = 0; mi < 4; ++mi) {
        bf16x8 af = *(const bf16x8*)(sA + (128 * wm + 32 * mi + l32) * LDS_STRIDE + (16 * ks + 8 * h) * 2);
#pragma unroll
        for (int ni = 0; ni < 2; ++ni) acc[mi][ni] = MFMA(bfr[ni], af, acc[mi][ni]);
      }
    }
    __builtin_amdgcn_s_setprio(0);
  }
  const float ALPHA = 1.189207115002721f;
  float s1[4], s2[4];
  f32x4 xv[2][2][4];
#define LN_LOAD_X(S, MI)                                                                                          \
  {                                                                                                               \
    const long row_ = rowbase + 128 * wm + 32 * (MI) + l32;                                                        \
    _Pragma("unroll") for (int ni = 0; ni < 2; ++ni)                                                              \
    _Pragma("unroll") for (int q4 = 0; q4 < 4; ++q4)                                                              \
      xv[S][ni][q4] = __builtin_nontemporal_load((const f32x4*)(p.x + row_ * 1024 + colbase + 64 * wn + 32 * ni + 8 * q4 + 4 * h)); \
  }
  LN_LOAD_X(0, 0);
#pragma unroll
  for (int mi = 0; mi < 4; ++mi) {
    if (mi < 3) LN_LOAD_X((mi + 1) & 1, mi + 1);
    __builtin_amdgcn_sched_barrier(0);
    float a1 = 0.f, a2 = 0.f;
#pragma unroll
    for (int ni = 0; ni < 2; ++ni)
#pragma unroll
      for (int q4 = 0; q4 < 4; ++q4) {
        const f32x4 xq = xv[mi & 1][ni][q4];
        const float xs[4] = {xq.x, xq.y, xq.z, xq.w};
#pragma unroll
        for (int e = 0; e < 4; ++e) {
          const float hv = ALPHA * xs[e] + acc[mi][ni][4 * q4 + e];
          acc[mi][ni][4 * q4 + e] = hv;
          a1 += hv;
          a2 += hv * hv;
        }
      }
    a1 += __shfl_xor(a1, 32);
    a2 += __shfl_xor(a2, 32);
    s1[mi] = a1; s2[mi] = a2;
  }
  __syncthreads();
  float2* part = (float2*)smem;
  if (h == 0) {
#pragma unroll
    for (int mi = 0; mi < 4; ++mi) part[wn * 256 + 128 * wm + 32 * mi + l32] = make_float2(s1[mi], s2[mi]);
  }
  __syncthreads();
  {
    const float2 p0 = part[tid], p1 = part[256 + tid];
    const unsigned long long bits = (unsigned long long)__float_as_uint(p0.x + p1.x) | ((unsigned long long)__float_as_uint(p0.y + p1.y) << 32);
    __hip_atomic_store((unsigned long long*)&p.lnst[(long)(rt * 8 + ct) * 256 + tid], bits, __ATOMIC_RELAXED, __HIP_MEMORY_SCOPE_AGENT);
  }
  asm volatile("s_waitcnt vmcnt(0)" ::: "memory");
  __syncthreads();
  if (tid == 0) {
    (void)xb_add(&p.ctr[4300 + rt], 1u);
    unsigned sp = 0;
    while (xb_ld(&p.ctr[4300 + rt]) < 8u) { __builtin_amdgcn_s_sleep(1); if (++sp > (1u << 18)) break; }
  }
  __syncthreads();
  float mu[4], rs[4];
  unsigned long long sv[4][8];
#pragma unroll
  for (int mi = 0; mi < 4; ++mi)
#pragma unroll
    for (int c = 0; c < 8; ++c)
      sv[mi][c] = __hip_atomic_load((unsigned long long*)&p.lnst[(long)(rt * 8 + c) * 256 + 128 * wm + 32 * mi + l32], __ATOMIC_RELAXED,
                                    __HIP_MEMORY_SCOPE_AGENT);
#pragma unroll
  for (int mi = 0; mi < 4; ++mi) {
    float t1 = 0.f, t2 = 0.f;
#pragma unroll
    for (int c = 0; c < 8; ++c) { t1 += __uint_as_float((unsigned)sv[mi][c]); t2 += __uint_as_float((unsigned)(sv[mi][c] >> 32)); }
    const float m_ = t1 * (1.f / 1024.f);
    const float var = fmaxf(t2 * (1.f / 1024.f) - m_ * m_, 0.f);
    mu[mi] = m_;
    rs[mi] = rsqrtf(var + 1e-5f);
  }
#pragma unroll
  for (int ni = 0; ni < 2; ++ni)
#pragma unroll
    for (int q4 = 0; q4 < 4; ++q4) {
      const int col = colbase + 64 * wn + 32 * ni + 8 * q4 + 4 * h;
      const f32x4 g4 = *(const f32x4*)(p.ln_g + col), b4 = *(const f32x4*)(p.ln_b + col);
#pragma unroll
      for (int mi = 0; mi < 4; ++mi) {
        const long row = rowbase + 128 * wm + 32 * mi + l32;
        f32x4 o;
        o.x = (acc[mi][ni][4 * q4 + 0] - mu[mi]) * rs[mi] * g4.x + b4.x;
        o.y = (acc[mi][ni][4 * q4 + 1] - mu[mi]) * rs[mi] * g4.y + b4.y;
        o.z = (acc[mi][ni][4 * q4 + 2] - mu[mi]) * rs[mi] * g4.z + b4.z;
        o.w = (acc[mi][ni][4 * q4 + 3] - mu[mi]) * rs[mi] * g4.w + b4.w;
        *(f32x4*)(p.out + row * 1024 + col) = o;
      }
    }
}


DI int vblock() { return (int)(blockIdx.x & 7) * (int)(gridDim.x >> 3) + (int)(blockIdx.x >> 3); }

DI void transpose_weight(const float* __restrict__ src, int src_ld, u16* __restrict__ dst, int n_rows, int kchunks, int gtid, int gsz, bool permute_in) {
  for (int i = gtid; i < n_rows * kchunks; i += gsz) {
    int n = i % n_rows, kc = i / n_rows;
    int orig = n;
    if (permute_in) orig = n < 1024 ? n : (n < 2560 ? n + 40 : (n < 2592 ? n - 2560 + 1024 : (n < 2600 ? n - 2592 + 1056 : -1)));
    unsigned r[4];
#pragma unroll
    for (int jj = 0; jj < 4; ++jj) {
      float a = 0.f, b = 0.f;
      if (orig >= 0) {
        a = src[(long)(kc * 8 + 2 * jj) * src_ld + orig];
        b = src[(long)(kc * 8 + 2 * jj + 1) * src_ld + orig];
      }
      r[jj] = pack2(a, b);
    }
    uint4 v; v.x = r[0]; v.y = r[1]; v.z = r[2]; v.w = r[3];
    *(uint4*)(dst + (long)n * (kchunks * 8) + kc * 8) = v;
  }
}

DI void phase0(const Params& p, char* smem) {
  const int tid = threadIdx.x;
  const int gtid = blockIdx.x * 128 + (tid & 127), gsz = gridDim.x * 128;
  if (tid < 128) {
  transpose_weight(p.w_in, 2600, p.winT, NZ, 128, gtid, gsz, true);
  transpose_weight(p.w_out, 1024, p.woutT, 1024, 128, gtid, gsz, false);
  transpose_weight(p.w_mem_kv, 512, p.wmemT, 512, 128, gtid, gsz, false);
  transpose_weight(p.w_glu, 256, p.wgluT, 256, 32, gtid, gsz, false);

  {
    const f32x4* __restrict__ xs = (const f32x4*)p.x;
    u32x4* __restrict__ xd = (u32x4*)p.xb;
    const long nitem = (long)NTOK * 1024 / 8;
    for (long i0 = gtid; i0 < nitem; i0 += 4L * gsz) {
      f32x4 a[4], b[4];
#pragma unroll
      for (int e = 0; e < 4; ++e) {
        long i = i0 + (long)e * gsz;
        if (i >= nitem) i = i0;
        a[e] = __builtin_nontemporal_load(&xs[2 * i]); b[e] = __builtin_nontemporal_load(&xs[2 * i + 1]);
      }
#pragma unroll
      for (int e = 0; e < 4; ++e) {
        long i = i0 + (long)e * gsz;
        if (i < nitem) {
          u32x4 o;
          o.x = pack2(a[e].x, a[e].y); o.y = pack2(a[e].z, a[e].w); o.z = pack2(b[e].x, b[e].y); o.w = pack2(b[e].z, b[e].w);
          xd[i] = o;
        }
      }
    }
  }
  } else {
  for (int i = gtid; i < 2048 * 8; i += gsz) {
    float ang = (float)(i >> 3) * c_inv8[i & 7];
    double c, s;
    sincos_rev((double)ang * 0.15915494309189533577, c, s);
    p.rope[i] = make_float2((float)c, (float)s);
  }
  for (int i = gtid; i < 16 * 64 * 64; i += gsz) {
    int g = i >> 12, pp = (i >> 6) & 63, s = i & 63;
    double pr, pi, fr, fi;
    lam_pow(p, g, pp, 63 - s, pr, pi);
    zoh_factor(p, g, pp, fr, fi);
    double cr = pr * fr - pi * fi, ci = pr * fi + pi * fr;
    unsigned re[8], im[8];
#pragma unroll
    for (int m2 = 0; m2 < 8; ++m2) {
      float vr[2], vi[2];
#pragma unroll
      for (int e = 0; e < 2; ++e) {
        int m = 2 * m2 + e;
        double br = p.b_re[(g * 64 + pp) * 16 + m], bi = p.b_im[(g * 64 + pp) * 16 + m];
        vr[e] = (float)(cr * br - ci * bi);
        vi[e] = (float)(cr * bi + ci * br);
      }
      re[m2] = pack2(vr[0], vr[1]);
      im[m2] = pack2(vi[0], vi[1]);
    }
    uint4* dr = (uint4*)(p.E + ((long)(g * 128 + pp) * 1024 + s * 16));
    uint4* di = (uint4*)(p.E + ((long)(g * 128 + 64 + pp) * 1024 + s * 16));
    uint4 v;
    v.x = re[0]; v.y = re[1]; v.z = re[2]; v.w = re[3]; dr[0] = v;
    v.x = re[4]; v.y = re[5]; v.z = re[6]; v.w = re[7]; dr[1] = v;
    v.x = im[0]; v.y = im[1]; v.z = im[2]; v.w = im[3]; di[0] = v;
    v.x = im[4]; v.y = im[5]; v.z = im[6]; v.w = im[7]; di[1] = v;
  }
  for (int i = gtid; i < 16 * 64 * 64; i += gsz) {
    int g = i >> 12, t = (i >> 6) & 63, pp = i & 63;
    double pr, pi;
    lam_pow(p, g, pp, t + 1, pr, pi);
#pragma unroll 4
    for (int n = 0; n < 16; ++n) {
      double cr = p.c_re[(g * 16 + n) * 64 + pp], ci = p.c_im[(g * 16 + n) * 64 + pp];
      long row = (long)g * 1024 + t * 16 + n;
      *(unsigned*)(p.W3 + row * UROW + 1024 + 2 * pp) = pack2((float)(cr * pr - ci * pi), (float)(-(cr * pi + ci * pr)));
    }
  }
    {
      const int wv = (tid >> 6) - 2, lane = tid & 63;
      float2* w_lp = (float2*)(smem + wv * 9216);
      float2* w_bb = (float2*)(smem + wv * 9216 + 512);
      for (int it = blockIdx.x * 2 + wv; it < 16 * 64; it += gridDim.x * 2) {
        const int g = it >> 6, j = it & 63;
        double pr, pi, fr, fi;
        lam_pow(p, g, lane, j, pr, pi);
        zoh_factor(p, g, lane, fr, fi);
        w_lp[lane] = make_float2((float)pr, (float)pi);
#pragma unroll
        for (int m = 0; m < 16; ++m) {
          double br = p.b_re[(g * 64 + lane) * 16 + m], bi = p.b_im[(g * 64 + lane) * 16 + m];
          w_bb[lane * 16 + m] = make_float2((float)(fr * br - fi * bi), (float)(fr * bi + fi * br));
        }
        asm volatile("s_waitcnt lgkmcnt(0)" ::: "memory");
        __builtin_amdgcn_wave_barrier();
        const int n = lane >> 2, m0 = (lane & 3) * 4;
        float acc4[4] = {0.f, 0.f, 0.f, 0.f};
#pragma unroll 1
        for (int qc = 0; qc < 4; ++qc) {
          f32x4 crv[4], civ[4];
#pragma unroll
          for (int q = 0; q < 4; ++q) {
            crv[q] = ((const f32x4*)(p.c_re + (g * 16 + n) * 64))[4 * qc + q];
            civ[q] = ((const f32x4*)(p.c_im + (g * 16 + n) * 64))[4 * qc + q];
          }
#pragma unroll
          for (int q = 0; q < 4; ++q) {
            const float cr4[4] = {crv[q].x, crv[q].y, crv[q].z, crv[q].w}, ci4[4] = {civ[q].x, civ[q].y, civ[q].z, civ[q].w};
#pragma unroll
            for (int e2 = 0; e2 < 4; ++e2) {
              const int pp = 16 * qc + 4 * q + e2;
              const float2 lp = w_lp[pp];
              const float tr = cr4[e2] * lp.x - ci4[e2] * lp.y, ti = cr4[e2] * lp.y + ci4[e2] * lp.x;
#pragma unroll
              for (int e = 0; e < 4; ++e) {
                const float2 bb = w_bb[pp * 16 + m0 + e];
                acc4[e] += tr * bb.x - ti * bb.y;
              }
            }
          }
        }
        f32x4 o = {acc4[0], acc4[1], acc4[2], acc4[3]};
        *(f32x4*)(p.kern + ((g * 64 + j) * 16 + n) * 16 + m0) = o;
        asm volatile("s_waitcnt lgkmcnt(0)" ::: "memory");
        __builtin_amdgcn_wave_barrier();
      }
    }
  }
}


DI void epi_inproj(const Params& p, int r0, int c0, const f32x16& acc) {
  const int lane = threadIdx.x & 63, l32 = lane & 31, h = lane >> 5;
  const long row = r0 + l32;
  const int pos = (int)row & 2047;
  if (c0 < 640) {
    float v[16];
#pragma unroll
    for (int i = 0; i < 16; ++i) v[i] = acc[i];
    if ((c0 & 63) == 0) {
      const f32x4* rp = (const f32x4*)(p.rope + pos * 8 + 4 * h);
      f32x4 t0 = rp[0], t1 = rp[1];
      float cc[4] = {t0.x, t0.z, t1.x, t1.z}, ss[4] = {t0.y, t0.w, t1.y, t1.w};
#pragma unroll
      for (int e = 0; e < 4; ++e) {
        float x1 = acc[e], x2 = acc[4 + e];
        v[e] = x1 * cc[e] - x2 * ss[e];
        v[4 + e] = x2 * cc[e] + x1 * ss[e];
      }
    }
    u16* dst = c0 < 512 ? p.qb + row * 512 + c0 : p.kb + row * 128 + (c0 - 512);
    const float qs = c0 < 512 ? QSCALE : 1.f;
#pragma unroll
    for (int q4 = 0; q4 < 4; ++q4)
      *(u32x2*)(dst + 8 * q4 + 4 * h) = pack4(v[4 * q4] * qs, v[4 * q4 + 1] * qs, v[4 * q4 + 2] * qs, v[4 * q4 + 3] * qs);
  } else if (c0 < 768) {
    const int b = (int)(row >> 11);
#pragma unroll
    for (int i = 0; i < 16; ++i) {
      int feat = c0 - 640 + crow(i, h), g = feat >> 6, d = feat & 63;
      p.vT[(long)((b * 2 + g) * 64 + d) * 2048 + pos] = f2bf(acc[i]);
    }
  } else if (c0 < 1024 || c0 == 2560) {
    float v[16];
#pragma unroll
    for (int i = 0; i < 16; ++i) v[i] = acc[i];
    const f32x4* rp = (const f32x4*)(p.rope + pos * 8);
    f32x4 t0 = rp[0], t1 = rp[1], t2 = rp[2], t3 = rp[3];
    float cc[4] = {t0.x, t1.x, t2.x, t3.x}, ss[4] = {t0.y, t1.y, t2.y, t3.y};
#pragma unroll
    for (int e = 0; e < 4; ++e) {
      float x = acc[e];
      float pv = __shfl_xor(x, 32);
      v[e] = h == 0 ? x * cc[e] - pv * ss[e] : x * cc[e] + pv * ss[e];
    }
    u16* dst = c0 < 1024 ? p.qib + row * 256 + (c0 - 768) : p.kib + row * 32;
#pragma unroll
    for (int q4 = 0; q4 < 4; ++q4) *(u32x2*)(dst + 8 * q4 + 4 * h) = pack4(v[4 * q4], v[4 * q4 + 1], v[4 * q4 + 2], v[4 * q4 + 3]);
  } else if (c0 < 1536 || (c0 >= 1792 && c0 < 2048) || (c0 >= 2304 && c0 < 2560)) {
    const int off = c0 < 1536 ? c0 - 1024 : (c0 < 2048 ? 512 + c0 - 1792 : 768 + c0 - 2304);
    u16* dst = p.gate + row * 1024 + off;
#pragma unroll
    for (int q4 = 0; q4 < 4; ++q4)
      *(u32x2*)(dst + 8 * q4 + 4 * h) = pack4(silu(acc[4 * q4]), silu(acc[4 * q4 + 1]), silu(acc[4 * q4 + 2]), silu(acc[4 * q4 + 3]));
  } else if (c0 < 1792) {
    const int b = (int)(row >> 11), c = pos >> 6, tl = pos & 63;
#pragma unroll
    for (int q4 = 0; q4 < 4; ++q4) {
      int f = c0 - 1536 + 8 * q4 + 4 * h, g = f >> 4, n0 = f & 15;
      *(u32x2*)(p.U + (long)((g * 16 + b) * 32 + c) * UROW + tl * 16 + n0) = pack4(acc[4 * q4], acc[4 * q4 + 1], acc[4 * q4 + 2], acc[4 * q4 + 3]);
    }
  } else if (c0 < 2304) {
    u16* dst = p.qm + row * 256 + (c0 - 2048);
#pragma unroll
    for (int q4 = 0; q4 < 4; ++q4)
      *(u32x2*)(dst + 8 * q4 + 4 * h) = pack4(acc[4 * q4] * QSCALE, acc[4 * q4 + 1] * QSCALE, acc[4 * q4 + 2] * QSCALE, acc[4 * q4 + 3] * QSCALE);
  } else if (c0 == 2592) {
    f32x4 o = {acc[0] * 0.0625f, acc[1] * 0.0625f, acc[2] * 0.0625f, acc[3] * 0.0625f};
    *(f32x4*)(p.wi + row * 8 + 4 * h) = o;
  }
}

DI void epi_memkv(const Params& p, int r0, int c0, const f32x16& acc) {
  const int lane = threadIdx.x & 63, l32 = lane & 31, h = lane >> 5;
  const long row = r0 + l32;
  if (c0 < 256) {
    u16* dst = p.mkb + row * 256 + c0;
#pragma unroll
    for (int q4 = 0; q4 < 4; ++q4) *(u32x2*)(dst + 8 * q4 + 4 * h) = pack4(acc[4 * q4], acc[4 * q4 + 1], acc[4 * q4 + 2], acc[4 * q4 + 3]);
  } else {
    const int b = (int)(row >> 8), m = (int)row & 255;
#pragma unroll
    for (int i = 0; i < 16; ++i) {
      int feat = c0 - 256 + crow(i, h), hm = feat >> 6, d = feat & 63;
      p.mvT[(long)((b * 4 + hm) * 64 + d) * 256 + m] = f2bf(acc[i]);
    }
  }
}

DI void w3_build(const Params& p, int first, int stride) {
  const int nitem = 16 * 1024 * 128;
  for (int i0 = first; i0 < nitem; i0 += 4 * stride) {
    f32x4 ka[4], kb[4];
#pragma unroll
    for (int e = 0; e < 4; ++e) {
      int i = i0 + e * stride;
      ka[e] = (f32x4){0.f, 0.f, 0.f, 0.f}; kb[e] = ka[e];
      if (i < nitem) {
        int row = i >> 7, ch = i & 127, s_ = ch >> 1, m0 = (ch & 1) * 8;
        int g = row >> 10, t = (row >> 4) & 63, n = row & 15;
        if (s_ <= t) {
          const float* kp = p.kern + ((g * 64 + (t - s_)) * 16 + n) * 16 + m0;
          ka[e] = *(const f32x4*)kp; kb[e] = *(const f32x4*)(kp + 4);
          if (s_ == t && (n >> 3) == (ch & 1)) {
            float dsk = p.d_skip[g * 16 + n];
            int k = n & 7;
            if (k == 0) ka[e].x += dsk; else if (k == 1) ka[e].y += dsk; else if (k == 2) ka[e].z += dsk; else if (k == 3) ka[e].w += dsk;
            else if (k == 4) kb[e].x += dsk; else if (k == 5) kb[e].y += dsk; else if (k == 6) kb[e].z += dsk; else kb[e].w += dsk;
          }
        }
      }
    }
#pragma unroll
    for (int e = 0; e < 4; ++e) {
      int i = i0 + e * stride;
      if (i < nitem) {
        int row = i >> 7, ch = i & 127;
        u32x4 o;
        o.x = pack2(ka[e].x, ka[e].y); o.y = pack2(ka[e].z, ka[e].w); o.z = pack2(kb[e].x, kb[e].y); o.w = pack2(kb[e].z, kb[e].w);
        *(u32x4*)(p.W3 + (long)row * UROW + ch * 8) = o;
      }
    }
  }
}

DI void phase1(const Params& p, char* smem) {
  const int n_g1 = 128 * 21, n_mkv = 32 * 4;
  if (gridDim.x == 512) {
    const int vb = vblock();
    gemm_big_stream(p.xb, p.winT, vb, 512, 2560, [](int it, int& rt, int& ct) { rt = it / 21; ct = it % 21; },
                    [&](int r0, int c0, const f32x16& a) { epi_inproj(p, r0, c0, a); }, smem);
    if (vb < 256) {
      int bt = 2560 + (vb >> 1), hf = vb & 1, rt = bt / 21, ct = bt % 21, r = rt * 256 + hf * 128;
      gemm_tile<false>(p.xb + (long)r * 1024, 1024, p.winT + (long)ct * 128 * 1024, 1024, 1024, r, ct * 128,
                       [&](int r0, int c0, const f32x16& a) { epi_inproj(p, r0, c0, a); }, smem);
    } else if (vb < 384) {
      int id = vb - 256, rt = id >> 2, ct = id & 3;
      gemm_tile<true>(p.mem + (long)rt * 128 * 1024, 1024, p.wmemT + (long)ct * 128 * 1024, 1024, 1024, rt * 128, ct * 128,
                      [&](int r0, int c0, const f32x16& a) { epi_memkv(p, r0, c0, a); }, smem);
    } else {
      w3_build(p, (vb - 384) * 256 + threadIdx.x, 128 * 256);
    }
    return;
  }
  for (int it = vblock(); it < n_g1 + n_mkv; it += gridDim.x) {
    if (it < n_g1) {
      int rt = it / 21, ct = it % 21;
      gemm_big(p.xb + (long)rt * 256 * 1024, 1024, p.winT + (long)ct * 128 * 1024, 1024, 1024, rt * 256, ct * 128,
               [&](int r0, int c0, const f32x16& a) { epi_inproj(p, r0, c0, a); }, smem);
    } else {
      int id = it - n_g1, rt = id >> 2, ct = id & 3;
      gemm_tile<true>(p.mem + (long)rt * 128 * 1024, 1024, p.wmemT + (long)ct * 128 * 1024, 1024, 1024, rt * 128, ct * 128,
                      [&](int r0, int c0, const f32x16& a) { epi_memkv(p, r0, c0, a); }, smem);
    }
  }
  w3_build(p, blockIdx.x * 256 + threadIdx.x, gridDim.x * 256);
}

DI unsigned fkey(float f) { unsigned u = __float_as_uint(f); return (u & 0x80000000u) ? ~u : (u | 0x80000000u); }
DI float funkey(unsigned k) { unsigned u = (k & 0x80000000u) ? (k & 0x7fffffffu) : ~k; return __uint_as_float(u); }

template <int NT>
DI void select_body(const Params& p, int b, int t0, int lane, int l32, int h, long tokbase) {
  asm volatile("" : "+v"(l32), "+v"(h));
  bf16x8 af[2];
  {
    int m = l32, mm = m & 3, hl = (m >> 2) & 1, jj = m >> 3;
    int tokA = 2 * hl + (jj >> 1), headA = 4 * (jj & 1) + mm;
    const u16* qa = p.qib + (tokbase + t0 + tokA) * 256 + headA * 32 + 8 * h;
    af[0] = *(const bf16x8*)qa;
    af[1] = *(const bf16x8*)(qa + 16);
  }
  float wv[2][8];
#pragma unroll
  for (int jt = 0; jt < 2; ++jt) {
    const float4* wp = (const float4*)(p.wi + (tokbase + t0 + 2 * h + jt) * 8);
    float4 a = wp[0], c = wp[1];
    wv[jt][0] = a.x; wv[jt][1] = a.y; wv[jt][2] = a.z; wv[jt][3] = a.w;
    wv[jt][4] = c.x; wv[jt][5] = c.y; wv[jt][6] = c.z; wv[jt][7] = c.w;
  }
  const int ntiles = ((t0 + 3) >> 5) + 1;
  const unsigned KEY_NINF = 0x007fffffu;
  unsigned sc[NT][2];
  unsigned kmax[2] = {0u, 0u}, kmin[2] = {0xffffffffu, 0xffffffffu};
  u32x4 kq0[2][4], kq1[2][4];
#define SEL_LOAD_GROUP(S, TG)                                                              \
  {                                                                                        \
    _Pragma("unroll") for (int e = 0; e < 4; ++e) {                                        \
      const u16* kp_ = p.kib + (tokbase + 32 * (4 * (TG) + e) + l32) * 32 + 8 * h;          \
      kq0[S][e] = *(const u32x4*)kp_;                                                      \
      kq1[S][e] = *(const u32x4*)(kp_ + 16);                                               \
    }                                                                                      \
  }
  SEL_LOAD_GROUP(0, 0);
#pragma unroll
  for (int tg = 0; tg < NT / 4; ++tg) {
    if (tg + 1 < NT / 4) SEL_LOAD_GROUP((tg + 1) & 1, tg + 1);
    __builtin_amdgcn_sched_barrier(0);
#pragma unroll
    for (int e = 0; e < 4; ++e) {
      const int tile = 4 * tg + e;
      f32x16 a;
#pragma unroll
      for (int i = 0; i < 16; ++i) a[i] = 0.f;
      a = MFMA(af[0], __builtin_bit_cast(bf16x8, kq0[tg & 1][e]), a);
      a = MFMA(af[1], __builtin_bit_cast(bf16x8, kq1[tg & 1][e]), a);
      const int key = 32 * tile + l32;
#pragma unroll
      for (int jt = 0; jt < 2; ++jt) {
        float pj[4];
#pragma unroll
        for (int j = 0; j < 4; ++j)
          pj[j] = __builtin_fmaf(wv[jt][j + 4], fmaxf(a[8 * jt + 4 + j], 0.f), wv[jt][j] * fmaxf(a[8 * jt + j], 0.f));
        float s = ((pj[0] + pj[1]) + (pj[2] + pj[3])) + 0.0f;
        int t = t0 + 2 * h + jt;
        unsigned k = key <= t ? fkey(s) : KEY_NINF;
        sc[tile][jt] = k;
        kmax[jt] = max(kmax[jt], k);
        kmin[jt] = min(kmin[jt], key <= t ? k : 0xffffffffu);
      }
    }
  }
#pragma unroll
  for (int jt = 0; jt < 2; ++jt)
#pragma unroll
    for (int o = 16; o >= 1; o >>= 1) {
      kmax[jt] = max(kmax[jt], (unsigned)__shfl_xor((int)kmax[jt], o));
      kmin[jt] = min(kmin[jt], (unsigned)__shfl_xor((int)kmin[jt], o));
    }
  unsigned lo[2], hi[2], thr[2];
  int chi[2], need[2];
  bool done[2];
#pragma unroll
  for (int jt = 0; jt < 2; ++jt) { lo[jt] = kmin[jt] - 1u; hi[jt] = kmax[jt]; chi[jt] = 0; need[jt] = 0; thr[jt] = 0; done[jt] = false; }
  for (int iter = 0; iter < 80; ++iter) {
    unsigned km[2];
#pragma unroll
    for (int jt = 0; jt < 2; ++jt) {
      if (!done[jt] && hi[jt] - lo[jt] <= 1u) { done[jt] = true; thr[jt] = hi[jt]; need[jt] = 256 - chi[jt]; }
      float fm = 0.5f * funkey(lo[jt]) + 0.5f * funkey(hi[jt]);
      unsigned k = fkey(fm);
      if (iter >= 7 || !(k > lo[jt] && k < hi[jt])) k = lo[jt] + ((hi[jt] - lo[jt]) >> 1);
      km[jt] = k;
    }
    if (__all(done[0] && done[1])) break;
    int cnt[2] = {0, 0};
#pragma unroll
    for (int tile = 0; tile < NT; ++tile) {
#pragma unroll
      for (int jt = 0; jt < 2; ++jt) cnt[jt] += (sc[tile][jt] > km[jt]) ? 1 : 0;
    }
#pragma unroll
    for (int jt = 0; jt < 2; ++jt) {
      cnt[jt] += __builtin_amdgcn_update_dpp(0, cnt[jt], 0xB1, 0xF, 0xF, true);
      cnt[jt] += __builtin_amdgcn_update_dpp(0, cnt[jt], 0x4E, 0xF, 0xF, true);
      cnt[jt] += __builtin_amdgcn_update_dpp(0, cnt[jt], 0x141, 0xF, 0xF, true);
      cnt[jt] += __builtin_amdgcn_update_dpp(0, cnt[jt], 0x140, 0xF, 0xF, true);
      const int ra0 = __builtin_amdgcn_readlane(cnt[jt], 0), ra1 = __builtin_amdgcn_readlane(cnt[jt], 16);
      const int rb0 = __builtin_amdgcn_readlane(cnt[jt], 32), rb1 = __builtin_amdgcn_readlane(cnt[jt], 48);
      int c = h ? (rb0 + rb1) : (ra0 + ra1);
      if (!done[jt]) {
        if (c == 256) { done[jt] = true; thr[jt] = km[jt]; need[jt] = 0; }
        else if (c > 256) lo[jt] = km[jt];
        else { hi[jt] = km[jt]; chi[jt] = c; }
      }
    }
  }
  unsigned W[2][2] = {{0u, 0u}, {0u, 0u}};
  int rem[2] = {need[0], need[1]};
  const bool anyties = __any(need[0] > 0 || need[1] > 0);
#pragma unroll
  for (int tile = 0; tile < NT; ++tile) {
    if (tile < ntiles) {
#pragma unroll
      for (int jt = 0; jt < 2; ++jt) {
        bool sel = sc[tile][jt] > thr[jt];
        if (anyties) {
          bool eq = (need[jt] > 0) && (sc[tile][jt] == thr[jt]);
          unsigned long long bm = __ballot(eq);
          unsigned myw = h ? (unsigned)(bm >> 32) : (unsigned)bm;
          int rank = __popc(myw & ((1u << l32) - 1u));
          sel = sel || (eq && rank < rem[jt]);
          rem[jt] = max(rem[jt] - __popc(myw), 0);
        }
        unsigned long long sm = __ballot(sel);
        unsigned word = h ? (unsigned)(sm >> 32) : (unsigned)sm;
        if (l32 == (tile & 31)) W[jt][tile >> 5] = word;
      }
    }
  }
#pragma unroll
  for (int jt = 0; jt < 2; ++jt) {
    int t = t0 + 2 * h + jt;
    p.mask[(tokbase + t) * 64 + l32] = W[jt][0];
    p.mask[(tokbase + t) * 64 + 32 + l32] = W[jt][1];
  }
}

DI void select_wave(const Params& p, int b, int t0) {
  int tid_ = threadIdx.x;
  asm volatile("" : "+v"(tid_));
  const int lane = tid_ & 63, l32 = lane & 31, h = lane >> 5;
  const long tokbase = (long)b * SEQ;
  if (t0 < 256) {
#pragma unroll
    for (int jt = 0; jt < 2; ++jt) {
      int t = t0 + 2 * h + jt;
#pragma unroll
      for (int w2 = 0; w2 < 2; ++w2) {
        int lo = (l32 + 32 * w2) * 32;
        unsigned word = (t >= lo + 31) ? 0xffffffffu : (t < lo ? 0u : ((2u << (t - lo)) - 1u));
        p.mask[(tokbase + t) * 64 + l32 + 32 * w2] = word;
      }
    }
    return;
  }
  const int nt_ = ((t0 + 3) >> 5) + 1;
  if (nt_ <= 16) select_body<16>(p, b, t0, lane, l32, h, tokbase);
  else if (nt_ <= 32) select_body<32>(p, b, t0, lane, l32, h, tokbase);
  else if (nt_ <= 48) select_body<48>(p, b, t0, lane, l32, h, tokbase);
  else select_body<64>(p, b, t0, lane, l32, h, tokbase);
}

template <int HPG, bool MASKED>
DI void attn_block(const u16* __restrict__ Q, int ldq, const u16* __restrict__ K, int ldk, const u16* __restrict__ VT, int ldv,
                   const unsigned* __restrict__ mrow, int nk64, int tok0, const u16* __restrict__ gatep, u16* __restrict__ catp,
                   char* smem) {
  int tid_ = threadIdx.x;
  asm volatile("" : "+v"(tid_));
  const int tid = tid_, lane = tid & 63, l32 = lane & 31, h = lane >> 5;
  const int tok = tok0 + l32 / HPG, hd = l32 % HPG;
  const u16* qp = Q + (long)tok * ldq + hd * 64 + 8 * h;
  bf16x8 qf[4];
#pragma unroll
  for (int kk = 0; kk < 4; ++kk) qf[kk] = *(const bf16x8*)(qp + 16 * kk);
  f32x16 o0, o1;
#pragma unroll
  for (int i = 0; i < 16; ++i) { o0[i] = 0.f; o1[i] = 0.f; }
  float m = NEG_INF, lsum = 0.f;
  const int srow = tid >> 3, scc = tid & 7;
  u32x4 rk[2], rv[2];
  u32x2 mw = {0xffffffffu, 0xffffffffu};
#define ATTN_LOAD_REGS(T)                                                                            \
  {                                                                                                  \
    const int key0_ = 64 * (T);                                                                      \
    _Pragma("unroll") for (int i = 0; i < 2; ++i) {                                                  \
      rk[i] = *(const u32x4*)(K + (long)(key0_ + srow + 32 * i) * ldk + scc * 8);                    \
      rv[i] = *(const u32x4*)(VT + (long)(srow + 32 * i) * ldv + key0_ + scc * 8);                   \
    }                                                                                                \
    if (MASKED) mw = *(const u32x2*)(mrow + (long)tok * 64 + 2 * (T));                               \
  }
#define ATTN_STORE_LDS(BUF)                                                                          \
  {                                                                                                  \
    char* kb_ = smem + (BUF) * 18432;                                                                \
    char* vb_ = kb_ + 9216;                                                                          \
    _Pragma("unroll") for (int i = 0; i < 2; ++i) {                                                  \
      *(u32x4*)(kb_ + (srow + 32 * i) * LDS_STRIDE + scc * 16) = rk[i];                              \
      *(u32x4*)(vb_ + (srow + 32 * i) * LDS_STRIDE + scc * 16) = rv[i];                              \
    }                                                                                                \
  }
  const long obase = (long)tok * 1024 + hd * 64;
  u32x2 gvv[2][4];
#pragma unroll
  for (int dt = 0; dt < 2; ++dt)
#pragma unroll
    for (int q4 = 0; q4 < 4; ++q4) gvv[dt][q4] = *(const u32x2*)(gatep + obase + 32 * dt + 8 * q4 + 4 * h);
  __syncthreads();
  ATTN_LOAD_REGS(0);
  ATTN_STORE_LDS(0);
  u32x2 mcur = mw;
  __syncthreads();
  for (int t = 0; t < nk64; ++t) {
    {
      const int tn = (t + 1 < nk64) ? t + 1 : t;
      ATTN_LOAD_REGS(tn);
    }
    __builtin_amdgcn_sched_barrier(0);
    const char* kb = smem + (t & 1) * 18432;
    const char* vb = kb + 9216;
    f32x16 sv[2];
#pragma unroll
    for (int st = 0; st < 2; ++st) {
#pragma unroll
      for (int i = 0; i < 16; ++i) sv[st][i] = 0.f;
#pragma unroll
      for (int kk = 0; kk < 4; ++kk) {
        bf16x8 kf = *(const bf16x8*)(kb + (32 * st + l32) * LDS_STRIDE + (16 * kk + 8 * h) * 2);
        sv[st] = MFMA(kf, qf[kk], sv[st]);
      }
    }
    float mt = NEG_INF;
#pragma unroll
    for (int st = 0; st < 2; ++st) {
      const unsigned wc = (st == 0 ? mcur.x : mcur.y) >> (4 * h);
#pragma unroll
      for (int i = 0; i < 16; ++i) {
        float x = sv[st][i];
        if (MASKED) {
          const int bi = (i & 3) + 8 * (i >> 2);
          const unsigned mm = (unsigned)__builtin_amdgcn_sbfe((int)wc, bi, 1);
          x = __uint_as_float((__float_as_uint(x) & mm) | (0xff800000u & ~mm));
        }
        sv[st][i] = x;
        mt = fmaxf(mt, x);
      }
    }
    mt = fmaxf(mt, __shfl_xor(mt, 32));
    const float mnew = fmaxf(m, mt);
    const float msafe = fmaxf(mnew, -1e30f);
    const float alpha = __builtin_amdgcn_exp2f(m - msafe);
    float ps = 0.f;
#pragma unroll
    for (int st = 0; st < 2; ++st)
#pragma unroll
      for (int i = 0; i < 16; ++i) {
        float pv = __builtin_amdgcn_exp2f(sv[st][i] - msafe);
        sv[st][i] = pv;
        ps += pv;
      }
    lsum = lsum * alpha + ps;
    m = mnew;
    if (!__all(alpha == 1.0f)) {
#pragma unroll
      for (int i = 0; i < 16; ++i) { o0[i] *= alpha; o1[i] *= alpha; }
    }
#pragma unroll
    for (int st = 0; st < 2; ++st)
#pragma unroll
      for (int ks = 0; ks < 2; ++ks) {
        u32x4 uu;
        uu.x = pack2(sv[st][8 * ks + 0], sv[st][8 * ks + 1]); uu.y = pack2(sv[st][8 * ks + 2], sv[st][8 * ks + 3]);
        uu.z = pack2(sv[st][8 * ks + 4], sv[st][8 * ks + 5]); uu.w = pack2(sv[st][8 * ks + 6], sv[st][8 * ks + 7]);
        bf16x8 pf = __builtin_bit_cast(bf16x8, uu);
#pragma unroll
        for (int dt = 0; dt < 2; ++dt) {
          const char* vp = vb + (32 * dt + l32) * LDS_STRIDE + (32 * st + 16 * ks + 4 * h) * 2;
          s16x4 a_ = *(const s16x4*)vp, c_ = *(const s16x4*)(vp + 16);
          bf16x8 vf = __builtin_shufflevector(a_, c_, 0, 1, 2, 3, 4, 5, 6, 7);
          if (dt == 0) o0 = MFMA(vf, pf, o0); else o1 = MFMA(vf, pf, o1);
        }
      }
    ATTN_STORE_LDS((t + 1) & 1);
    mcur = mw;
    __syncthreads();
  }
  lsum += __shfl_xor(lsum, 32);
  const float inv = 1.f / lsum;
#pragma unroll
  for (int dt = 0; dt < 2; ++dt)
#pragma unroll
    for (int q4 = 0; q4 < 4; ++q4) {
      int d = 32 * dt + 8 * q4 + 4 * h;
      u32x2 gv = gvv[dt][q4];
      float g0 = __uint_as_float(gv.x << 16), g1 = __uint_as_float(gv.x & 0xffff0000u);
      float g2 = __uint_as_float(gv.y << 16), g3 = __uint_as_float(gv.y & 0xffff0000u);
      float v0, v1, v2, v3;
      if (dt == 0) { v0 = o0[4 * q4]; v1 = o0[4 * q4 + 1]; v2 = o0[4 * q4 + 2]; v3 = o0[4 * q4 + 3]; }
      else { v0 = o1[4 * q4]; v1 = o1[4 * q4 + 1]; v2 = o1[4 * q4 + 2]; v3 = o1[4 * q4 + 3]; }
      u32x2 ov;
      ov.x = pack2(v0 * inv * g0, v1 * inv * g1);
      ov.y = pack2(v2 * inv * g2, v3 * inv * g3);
      *(u32x2*)(catp + obase + d) = ov;
    }
}

DI void phase2(const Params& p, char* smem, int parts = 7) {
  const int w = threadIdx.x >> 6;
  const int n_sel = 16 * 128, n_g1 = 128, n_mem = 16 * 4 * 16, n_pad = 256;
  for (int it0 = blockIdx.x; it0 < n_sel + n_mem + n_pad + n_g1; it0 += gridDim.x) {
    int it;
    if (it0 < n_sel) it = it0;
    else if (it0 < n_sel + n_mem) it = it0 + n_g1;
    else if (it0 < n_sel + n_mem + n_pad) continue;
    else it = n_sel + (it0 - n_sel - n_mem - n_pad);
    if (it < n_sel) {
      if (!(parts & 1)) continue;
      int grp = 127 - (it >> 4), b = it & 15;
      select_wave(p, b, grp * 16 + w * 4);
    } else if (it < n_sel + n_g1) {
      if (!(parts & 2)) continue;
      int id = it - n_sel, g = id >> 3, rt = (id >> 1) & 3, kh = id & 1;
      gemm_tile<false>(p.U + ((long)g * 512 + rt * 128) * UROW + kh * 512, UROW, p.E + (long)g * 128 * 1024 + kh * 512, 1024, 512, rt * 128, 0,
                       [&](int r0, int c0, const f32x16& a) {
                         const int lane = threadIdx.x & 63, l32 = lane & 31, h = lane >> 5;
                         float* dst = p.Sbuf + (long)kh * (8192 * 128) + ((long)g * 512 + r0 + l32) * 128 + c0;
#pragma unroll
                         for (int q4 = 0; q4 < 4; ++q4) {
                           f32x4 o = {a[4 * q4], a[4 * q4 + 1], a[4 * q4 + 2], a[4 * q4 + 3]};
                           *(f32x4*)(dst + 8 * q4 + 4 * h) = o;
                         }
                       }, smem);
    } else {
      if (!(parts & 4)) continue;
      int id = it - n_sel - n_g1;
      int b = id >> 6, hm = (id >> 4) & 3, tile = id & 15;
      const long tb = (long)b * SEQ;
      attn_block<1, false>(p.qm + tb * 256 + hm * 64, 256, p.mkb + (long)b * 256 * 256 + hm * 64, 256,
                           p.mvT + (long)(b * 4 + hm) * 64 * 256, 256, nullptr, 4, tile * 128 + w * 32,
                           p.gate + tb * 1024 + 768 + hm * 64, p.cat + tb * 1024 + 768 + hm * 64, smem);
    }
  }
}

DI void phase3(const Params& p, char* smem) {
  const int w = threadIdx.x >> 6;
  {
    const int gtid = blockIdx.x * 256 + threadIdx.x;
    if (gtid < 16 * 16 * 64) {
      int g = gtid >> 10, b = (gtid >> 6) & 15, pp = gtid & 63;
      float sr[32], si[32];
      const long row0 = (long)(g * 16 + b) * 32;
#pragma unroll
      for (int c = 0; c < 32; ++c) {
        sr[c] = p.Sbuf[(row0 + c) * 128 + pp] + p.Sbuf[8192 * 128 + (row0 + c) * 128 + pp];
        si[c] = p.Sbuf[(row0 + c) * 128 + 64 + pp] + p.Sbuf[8192 * 128 + (row0 + c) * 128 + 64 + pp];
      }
      double lr, li;
      lam_pow(p, g, pp, 64, lr, li);
      float ar = (float)lr, ai = (float)li;
      float xr = 0.f, xi = 0.f;
#pragma unroll
      for (int c = 0; c < 32; ++c) {
        *(unsigned*)(p.U + (row0 + c) * UROW + 1024 + 2 * pp) = pack2(xr, xi);
        float nr = ar * xr - ai * xi + sr[c];
        float ni = ar * xi + ai * xr + si[c];
        xr = nr; xi = ni;
      }
    }
  }
  const int xcd = blockIdx.x & 7, nper = gridDim.x >> 3;
  for (int j = blockIdx.x >> 3; j < 256; j += nper) {
    int tt = 63 - (j >> 2), r = j & 3, b = 2 * xcd + (r >> 1), g = r & 1;
    if (nper == 64) {
      const int q = (j >> 2) & 15, k = j >> 6;
      tt = k == 0 ? 63 - q : (k == 1 ? 32 + q : (k == 2 ? 31 - q : q));
    }
    const long tb = (long)b * SEQ;
    attn_block<4, true>(p.qb + tb * 512 + g * 256, 512, p.kb + tb * 128 + g * 64, 128, p.vT + (long)(b * 2 + g) * 64 * 2048, 2048,
                        p.mask + tb * 64, (tt >> 1) + 1, tt * 32 + w * 8, p.gate + tb * 1024 + g * 256, p.cat + tb * 1024 + g * 256, smem);
  }
}

DI void phase4(const Params& p, char* smem) {
  for (int it = vblock(); it < 16 * 4 * 8; it += gridDim.x) {
    int g = it >> 5, rt = (it >> 3) & 3, ct = it & 7;
    gemm_tile<false>(p.U + ((long)g * 512 + rt * 128) * UROW, UROW, p.W3 + ((long)g * 1024 + ct * 128) * UROW, UROW, UROW, rt * 128, ct * 128,
                     [&](int r0, int c0, const f32x16& a) {
                       const int lane = threadIdx.x & 63, l32 = lane & 31, h = lane >> 5;
                       const int row = r0 + l32, b = row >> 5, c = row & 31;
#pragma unroll
                       for (int q4 = 0; q4 < 4; ++q4) {
                         int f = c0 + 8 * q4 + 4 * h, t = f >> 4, n0 = f & 15;
                         long tok = (long)b * SEQ + c * 64 + t;
                         *(u32x2*)(p.yact + tok * 256 + g * 16 + n0) =
                             pack4(gelu_tanh(a[4 * q4]), gelu_tanh(a[4 * q4 + 1]), gelu_tanh(a[4 * q4 + 2]), gelu_tanh(a[4 * q4 + 3]));
                       }
                     }, smem);
  }
}

DI void phase5(const Params& p, char* smem) {
  for (int it = vblock(); it < 256 * 2; it += gridDim.x) {
    int rt = it >> 1, ct = it & 1;
    gemm_tile<false>(p.yact + (long)rt * 128 * 256, 256, p.wgluT + (long)ct * 128 * 256, 256, 256, rt * 128, ct * 128,
                     [&](int r0, int c0, const f32x16& a) {
                       const int lane = threadIdx.x & 63, l32 = lane & 31, h = lane >> 5;
                       const long row = r0 + l32;
                       f32x4 bg[4];
                       u32x2 yv[4], gv[4];
#pragma unroll
                       for (int q4 = 0; q4 < 4; ++q4) {
                         int col = c0 + 8 * q4 + 4 * h;
                         bg[q4] = *(const f32x4*)(p.b_glu + col);
                         yv[q4] = *(const u32x2*)(p.yact + row * 256 + col);
                         gv[q4] = *(const u32x2*)(p.gate + row * 1024 + 512 + col);
                       }
#pragma unroll
                       for (int q4 = 0; q4 < 4; ++q4) {
                         int col = c0 + 8 * q4 + 4 * h;
                         float y4[4] = {bflo(yv[q4].x), bfhi(yv[q4].x), bflo(yv[q4].y), bfhi(yv[q4].y)};
                         float g4[4] = {bflo(gv[q4].x), bfhi(gv[q4].x), bflo(gv[q4].y), bfhi(gv[q4].y)};
                         float b4[4] = {bg[q4].x, bg[q4].y, bg[q4].z, bg[q4].w};
                         float o[4];
#pragma unroll
                         for (int e = 0; e < 4; ++e) {
                           float v = a[4 * q4 + e] + b4[e];
                           float sg = 1.f / (1.f + __expf(-v));
                           o[e] = y4[e] * sg * g4[e];
                         }
                         *(u32x2*)(p.cat + row * 1024 + 512 + col) = pack4(o[0], o[1], o[2], o[3]);
                       }
                     }, smem);
  }
}

DI void phase6(const Params& p, char* smem) {
  for (int it = vblock(); it < 128 * 8; it += gridDim.x) {
    int rt = it >> 3, ct = it & 7;
    gemm_big_ln(p, p.cat + (long)rt * 256 * 1024, 1024, p.woutT + (long)ct * 128 * 1024, 1024, 1024, rt, ct, smem);
  }
}

DI void phase7(const Params& p) {
  const int lane = threadIdx.x & 63, w = threadIdx.x >> 6;
  const int stride = gridDim.x * 4;
  int row = blockIdx.x * 4 + w;
  if (row >= NTOK) return;
  f32x4 gv[4], bv[4];
#pragma unroll
  for (int i = 0; i < 4; ++i) { gv[i] = ((const f32x4*)p.ln_g)[lane + 64 * i]; bv[i] = ((const f32x4*)p.ln_b)[lane + 64 * i]; }
  f32x4 v[4], vn[4];
#pragma unroll
  for (int i = 0; i < 4; ++i) v[i] = ((const f32x4*)(p.out + (long)row * 1024))[lane + 64 * i];
  for (; row < NTOK; row += stride) {
    const int nrow = (row + stride < NTOK) ? row + stride : row;
#pragma unroll
    for (int i = 0; i < 4; ++i) vn[i] = ((const f32x4*)(p.out + (long)nrow * 1024))[lane + 64 * i];
    float s = 0.f;
#pragma unroll
    for (int i = 0; i < 4; ++i) s += (v[i].x + v[i].y) + (v[i].z + v[i].w);
#pragma unroll
    for (int o = 32; o >= 1; o >>= 1) s += __shfl_xor(s, o);
    float mu = s * (1.f / 1024.f);
    float q = 0.f;
#pragma unroll
    for (int i = 0; i < 4; ++i) {
      float a = v[i].x - mu, b = v[i].y - mu, c = v[i].z - mu, d = v[i].w - mu;
      q += (a * a + b * b) + (c * c + d * d);
    }
#pragma unroll
    for (int o = 32; o >= 1; o >>= 1) q += __shfl_xor(q, o);
    float rs = rsqrtf(q * (1.f / 1024.f) + 1e-5f);
    f32x4* rp = (f32x4*)(p.out + (long)row * 1024);
#pragma unroll
    for (int i = 0; i < 4; ++i) {
      f32x4 o;
      o.x = (v[i].x - mu) * rs * gv[i].x + bv[i].x;
      o.y = (v[i].y - mu) * rs * gv[i].y + bv[i].y;
      o.z = (v[i].z - mu) * rs * gv[i].z + bv[i].z;
      o.w = (v[i].w - mu) * rs * gv[i].w + bv[i].w;
      rp[lane + 64 * i] = o;
    }
#pragma unroll
    for (int i = 0; i < 4; ++i) v[i] = vn[i];
  }
}


#define XB_TMO      128
#define XB_XCNT(j)  (256  + 64 * (j))
#define XB_XSUB(j)  (1280 + 64 * (j))
#define XB_XGEN(j)  (2304 + 64 * (j))
#define XB_TOP      3328
#define XB_TOPGEN   3392
#define XCD_BAR_WORDS 3456
#define XB_SPIN_CAP (1u << 18)
#define LAS __attribute__((address_space(3)))

DI unsigned xb_ld(unsigned* p) { return __hip_atomic_load(p, __ATOMIC_RELAXED, __HIP_MEMORY_SCOPE_AGENT); }
DI unsigned xb_add(unsigned* p, unsigned v) { return __hip_atomic_fetch_add(p, v, __ATOMIC_RELAXED, __HIP_MEMORY_SCOPE_AGENT); }
DI unsigned xb_xcc_id() { return (unsigned)__builtin_amdgcn_s_getreg((3 << 11) | 20) & 0xFu; }
#define XB_SPIN(cond, bar) do { unsigned _sp = 0; while (cond) { __builtin_amdgcn_s_sleep(1); \
    if ((++_sp & 255u) == 0u) { if (xb_ld(&(bar)[XB_TMO])) break; if (_sp > XB_SPIN_CAP) { atomicAdd(&(bar)[XB_TMO], 1u); break; } } } } while (0)

struct XcdBarrier { unsigned* bar; unsigned x; volatile LAS unsigned* st; };

DI XcdBarrier xcd_barrier_post(unsigned* bar, volatile LAS unsigned* st) {
  XcdBarrier b; b.bar = bar; b.x = xb_xcc_id(); b.st = st;
  if (threadIdx.x == 0) (void)xb_add(&bar[XB_XCNT(b.x)], 1u);
  return b;
}
DI void xcd_barrier_complete(unsigned* bar, unsigned x, unsigned& nloc, unsigned& nx) {
  const unsigned G = gridDim.x * gridDim.y * gridDim.z;
  unsigned sum, cnt, mine, sp = 0u;
  for (;;) {
    sum = 0u; cnt = 0u; mine = 0u;
#pragma unroll
    for (unsigned j = 0; j < 16; ++j) { const unsigned c = xb_ld(&bar[XB_XCNT(j)]); sum += c; cnt += (c > 0u) ? 1u : 0u; mine = (j == x) ? c : mine; }
    if (sum == G) break;
    __builtin_amdgcn_s_sleep(1);
    if ((++sp & 255u) == 0u) { if (xb_ld(&bar[XB_TMO])) break; if (sp > XB_SPIN_CAP) { atomicAdd(&bar[XB_TMO], 1u); break; } }
  }
  nloc = mine > 0u ? mine : 1u; nx = cnt > 0u ? cnt : 1u;
}
DI void xcd_barrier(const XcdBarrier& b) {
  asm volatile("s_waitcnt vmcnt(0)" ::: "memory");
  __syncthreads();
  if (threadIdx.x == 0) {
    unsigned* bar = b.bar;
    __builtin_amdgcn_s_waitcnt(0);
    unsigned nloc = b.st[0], nx = b.st[1];
    if (nloc == 0u) { xcd_barrier_complete(bar, b.x, nloc, nx); b.st[0] = nloc; b.st[1] = nx; }
    const unsigned old = xb_add(&bar[XB_XSUB(b.x)], 1u);
    const unsigned gen = old / nloc;
    if (old + 1u == (gen + 1u) * nloc) {
      __builtin_amdgcn_fence(__ATOMIC_RELEASE, "agent");
      asm volatile("s_waitcnt vmcnt(0)" ::: "memory");
      const unsigned og = xb_add(&bar[XB_TOP], 1u);
      const unsigned tg = og / nx;
      if (og + 1u == (tg + 1u) * nx) xb_add(&bar[XB_TOPGEN], 1u);
      else XB_SPIN(xb_ld(&bar[XB_TOPGEN]) == tg, bar);
      __builtin_amdgcn_fence(__ATOMIC_ACQUIRE, "agent");
      xb_add(&bar[XB_XGEN(b.x)], 1u);
      asm volatile("s_waitcnt vmcnt(0)" ::: "memory");
    } else {
      XB_SPIN(xb_ld(&bar[XB_XGEN(b.x)]) == gen, bar);
      __builtin_amdgcn_fence(__ATOMIC_ACQUIRE, "agent");
      asm volatile("s_waitcnt vmcnt(0)" ::: "memory");
    }
  }
  __syncthreads();
}

__global__ void __launch_bounds__(256, 2) mega(Params p, int ph0, int ph1) {
  __shared__ __attribute__((aligned(16))) char smem[SMEM_BYTES];
  cg::grid_group grid = cg::this_grid();
  __shared__ uint4 xb_words;
  if (threadIdx.x == 0) xb_words = make_uint4(0u, 0u, 0u, 0u);
  __syncthreads();
  XcdBarrier xb = xcd_barrier_post(p.bar, (volatile LAS unsigned*)&xb_words);
  if (ph0 < 0) grid.sync();
#define GRID_SYNC() xcd_barrier(xb)
#ifndef DUP_MASK
#define DUP_MASK 0
#endif
#define RUN_PHASE(N, CALL)                          \
  if (ph0 <= N && N < ph1) {                       \
    CALL;                                          \
    if ((DUP_MASK >> N) & 1) { GRID_SYNC(); CALL; } \
    if (N + 1 < ph1) GRID_SYNC();                  \
  }
  RUN_PHASE(0, phase0(p, smem))
  RUN_PHASE(1, phase1(p, smem))
  RUN_PHASE(2, phase2(p, smem))
  if ((DUP_MASK >> 8) & 7) { GRID_SYNC(); phase2(p, smem, (DUP_MASK >> 8) & 7); GRID_SYNC(); }
  RUN_PHASE(3, phase3(p, smem))
  RUN_PHASE(4, phase4(p, smem))
  RUN_PHASE(5, phase5(p, smem))
  RUN_PHASE(6, phase6(p, smem))
  if ((DUP_MASK >> 12) & 1) { for (int i = 0; i < 8; ++i) GRID_SYNC(); }
  if ((DUP_MASK >> 13) & 3) {
    GRID_SYNC();
    for (int it = vblock(); it < 128 * 21; it += gridDim.x) {
      int rt = it / 21, ct = it % 21;
      if ((DUP_MASK >> 13) & 1) { rt = 0; ct = 0; }
      gemm_big(p.xb + (long)rt * 256 * 1024, 1024, p.winT + (long)ct * 128 * 1024, 1024, 1024, 0, 0,
               [&](int r0, int c0, const f32x16& a) {
                 const int lane = threadIdx.x & 63, l32 = lane & 31, h = lane >> 5;
#pragma unroll
                 for (int q4 = 0; q4 < 4; ++q4) *(u32x2*)(p.scratch + (long)(r0 + l32) * 128 + c0 + 8 * q4 + 4 * h) = pack4(a[4 * q4], a[4 * q4 + 1], a[4 * q4 + 2], a[4 * q4 + 3]);
               }, smem);
    }
  }
}

extern "C" void kernel_launch(void* const* d_in, const int* in_sizes, int n_in, void* d_out, int out_size, void* d_ws,
                              size_t ws_size, hipStream_t stream) {
  static int grid_blocks = 0;
  if (!grid_blocks) {
    int dev = 0, cus = 0, per_cu = 0;
    hipGetDevice(&dev);
    hipDeviceGetAttribute(&cus, hipDeviceAttributeMultiprocessorCount, dev);
    hipOccupancyMaxActiveBlocksPerMultiprocessor(&per_cu, mega, 256, 0);
    if (per_cu < 1) per_cu = 1;
    if (per_cu > 2) per_cu = 2;
    grid_blocks = cus * per_cu;
  }
  Params p{};
  p.x = (const float*)d_in[0]; p.mem = (const float*)d_in[1]; p.w_in = (const float*)d_in[2]; p.w_mem_kv = (const float*)d_in[3];
  p.lam_re = (const float*)d_in[4]; p.lam_im = (const float*)d_in[5]; p.log_dt = (const float*)d_in[6];
  p.b_re = (const float*)d_in[7]; p.b_im = (const float*)d_in[8]; p.c_re = (const float*)d_in[9]; p.c_im = (const float*)d_in[10];
  p.d_skip = (const float*)d_in[11]; p.w_glu = (const float*)d_in[12]; p.b_glu = (const float*)d_in[13];
  p.w_out = (const float*)d_in[14]; p.ln_g = (const float*)d_in[15]; p.ln_b = (const float*)d_in[16];
  p.out = (float*)d_out;
  char* ws = (char*)d_ws;
  size_t off = 0;
  auto take = [&](size_t bytes) { char* r = ws + off; off += (bytes + 255) & ~(size_t)255; return r; };
  p.winT = (u16*)take((size_t)NZ * 1024 * 2);
  p.woutT = (u16*)take((size_t)1024 * 1024 * 2);
  p.wmemT = (u16*)take((size_t)512 * 1024 * 2);
  p.wgluT = (u16*)take((size_t)256 * 256 * 2);
  p.qb = (u16*)take((size_t)NTOK * 512 * 2);
  p.kb = (u16*)take((size_t)NTOK * 128 * 2);
  p.vT = (u16*)take((size_t)NTOK * 128 * 2);
  p.qib = (u16*)take((size_t)NTOK * 256 * 2);
  p.kib = (u16*)take((size_t)NTOK * 32 * 2);
  p.gate = (u16*)take((size_t)NTOK * 1024 * 2);
  p.qm = (u16*)take((size_t)NTOK * 256 * 2);
  p.U = (u16*)take((size_t)8192 * UROW * 2);
  p.mkb = (u16*)take((size_t)4096 * 256 * 2);
  p.mvT = (u16*)take((size_t)4096 * 256 * 2);
  p.E = (u16*)take((size_t)16 * 128 * 1024 * 2);
  p.W3 = (u16*)take((size_t)16 * 1024 * UROW * 2);
  p.yact = (u16*)take((size_t)NTOK * 256 * 2);
  p.cat = (u16*)take((size_t)NTOK * 1024 * 2);
  p.wi = (float*)take((size_t)NTOK * 8 * 4);
  p.Sbuf = (float*)take((size_t)2 * 8192 * 128 * 4);
  p.kern = (float*)take((size_t)16 * 64 * 256 * 4);
  p.mask = (unsigned*)take((size_t)NTOK * 64 * 4);
  p.rope = (float2*)take((size_t)2048 * 8 * 8);
  p.bar = (unsigned*)take((size_t)(XCD_BAR_WORDS + 4608) * 4);
  p.ctr = p.bar + XCD_BAR_WORDS;
  hipMemsetAsync(p.bar, 0, (size_t)(XCD_BAR_WORDS + 4608) * 4, stream);
  p.xb = (u16*)take((size_t)NTOK * 1024 * 2);
  p.scratch = (u16*)take((size_t)256 * 128 * 2);
  p.lnst = (float2*)take((size_t)128 * 8 * 256 * 8);
  int ph0 = 0, ph1 = 7;
  void* args[] = {&p, &ph0, &ph1};
  hipError_t e = hipLaunchCooperativeKernel((void*)mega, dim3(grid_blocks), dim3(256), args, 0, stream);
  if (e != hipSuccess) fprintf(stderr, "cooperative launch failed: %s (grid %d)\n", hipGetErrorString(e), grid_blocks);
}
```
